# Optimizing an MI355X kernel written in HIP

```python
import math
import jax, jax.numpy as jnp
from jax import lax
import numpy as np

D_MODEL = 1024
BATCH = 8
SEQ = 4096
DEPTH = 2

N_HEADS = 8
N_KV_HEADS = 2
HEAD_DIM = 64
ROPE_DIM = HEAD_DIM // 4
ROPE_THETA = 500000.0
IDX_HEADS = 4
IDX_DIM = 64
TOPK_MAX = 256
Q_BLOCK = 128
SGU_CHUNK = 128
SGU_GROUPS = 4
SGU_WIDTH = 512
SGU_GROUP_DIM = SGU_WIDTH // SGU_GROUPS
D_FF = 4 * D_MODEL
ALPHA = (2 * DEPTH) ** 0.25
BETA = (8 * DEPTH) ** -0.25
LN_EPS = 1e-5

ATT_Q = N_HEADS * HEAD_DIM
ATT_KV = N_KV_HEADS * HEAD_DIM
IDX_Q = IDX_HEADS * IDX_DIM
IDX_K = IDX_DIM
IDX_W = IDX_HEADS
SPLITS = [ATT_Q, ATT_KV, ATT_KV, IDX_Q, IDX_K, IDX_W, SGU_WIDTH, SGU_WIDTH, D_MODEL, D_MODEL]
N_IN = int(sum(SPLITS))
SPLIT_POINTS = [int(s) for s in np.cumsum(SPLITS)[:-1]]
V_START = ATT_Q + ATT_KV
V_END = V_START + ATT_KV

kernel_name = "hybrid_dsa_gmlp_deepnorm"


def layer_norm(x, g, b):
    xf = x.astype(jnp.float32)
    mu = jnp.mean(xf, axis=-1, keepdims=True)
    var = jnp.mean(jnp.square(xf - mu), axis=-1, keepdims=True)
    return ((xf - mu) * lax.rsqrt(var + LN_EPS) * g.astype(jnp.float32) + b.astype(jnp.float32)).astype(x.dtype)


def rope_tables(positions):
    inv_freq = ROPE_THETA ** (-jnp.arange(0, ROPE_DIM, 2, dtype=jnp.float32) / ROPE_DIM)
    ang = positions.astype(jnp.float32)[..., None] * inv_freq
    return jnp.cos(ang)[:, :, None, :], jnp.sin(ang)[:, :, None, :]


def partial_rope(x, cos, sin):
    xr, xp = x[..., :ROPE_DIM], x[..., ROPE_DIM:]
    x1, x2 = xr[..., :ROPE_DIM // 2], xr[..., ROPE_DIM // 2:]
    c = cos.astype(x.dtype)
    s = sin.astype(x.dtype)
    rot = jnp.concatenate([x1 * c - x2 * s, x2 * c + x1 * s], axis=-1)
    return jnp.concatenate([rot, xp], axis=-1)


def dsa_attention(q, k, v, q_idx, k_idx, w_idx):
    B, S = q.shape[0], q.shape[1]
    topk = min(TOPK_MAX, S // 4)
    nb = S // Q_BLOCK
    rep = N_HEADS // N_KV_HEADS
    key_pos = jnp.arange(S)
    k_idx32 = k_idx.astype(jnp.float32)
    idx_scale = (IDX_HEADS ** -0.5) * (IDX_DIM ** -0.5)
    att_scale = HEAD_DIM ** -0.5

    def to_blocks(a):
        return jnp.moveaxis(a.reshape((B, nb, Q_BLOCK) + a.shape[2:]), 1, 0)

    def one_block(args):
        qb, qib, wb, blk = args
        q_pos = blk * Q_BLOCK + jnp.arange(Q_BLOCK)
        causal = key_pos[None, :] <= q_pos[:, None]
        logits = jnp.einsum('bqhd,bsd->bqhs', qib.astype(jnp.float32), k_idx32)
        scores = jnp.einsum('bqhs,bqh->bqs', jax.nn.relu(logits), wb.astype(jnp.float32) * idx_scale)
        scores = jnp.where(causal[None], scores, -jnp.inf)
        _, idx = lax.top_k(scores, topk)
        valid = idx <= q_pos[None, :, None]
        k_sel = jax.vmap(lambda a, i: a[i])(k, idx)
        v_sel = jax.vmap(lambda a, i: a[i])(v, idx)
        qg = qb.reshape(B, Q_BLOCK, N_KV_HEADS, rep, HEAD_DIM)
        s = jnp.einsum('bqgrd,bqkgd->bqgrk', qg.astype(jnp.float32), k_sel.astype(jnp.float32)) * att_scale
        s = jnp.where(valid[:, :, None, None, :], s, -jnp.inf)
        p = jax.nn.softmax(s, axis=-1).astype(v.dtype)
        o = jnp.einsum('bqgrk,bqkgd->bqgrd', p, v_sel)
        return o.reshape(B, Q_BLOCK, N_HEADS * HEAD_DIM)

    out = lax.map(one_block, (to_blocks(q), to_blocks(q_idx), to_blocks(w_idx), jnp.arange(nb)))
    return jnp.moveaxis(out, 0, 1).reshape(B, S, N_HEADS * HEAD_DIM)


def spatial_gating(u, v, w_s, b_s, g_v, b_v):
    B, S = v.shape[0], v.shape[1]
    v = layer_norm(v, g_v, b_v)
    nc = S // SGU_CHUNK
    vc = v.reshape(B, nc, SGU_CHUNK, SGU_GROUPS, SGU_GROUP_DIM)
    mask = jnp.tril(jnp.ones((SGU_CHUNK, SGU_CHUNK), dtype=bool))
    w = jnp.where(mask[None], w_s, 0)
    mixed = jnp.einsum('gts,bcsgd->bctgd', w, vc) + jnp.swapaxes(b_s, 0, 1)[None, None, :, :, None]
    return u * mixed.reshape(B, S, SGU_WIDTH)


def hybrid_mixer(x, cos, sin, w_in, w_s, b_s, ln_v_g, ln_v_b, w_oa, w_ob, w_out):
    B, S = x.shape[0], x.shape[1]
    proj = x @ w_in
    q, k, v, qi, ki, wi, u, vg, ga, gb = jnp.split(proj, SPLIT_POINTS, axis=-1)
    q = partial_rope(q.reshape(B, S, N_HEADS, HEAD_DIM), cos, sin)
    k = partial_rope(k.reshape(B, S, N_KV_HEADS, HEAD_DIM), cos, sin)
    v = v.reshape(B, S, N_KV_HEADS, HEAD_DIM)
    qi = partial_rope(qi.reshape(B, S, IDX_HEADS, IDX_DIM), cos, sin)
    ki = partial_rope(ki.reshape(B, S, 1, IDX_DIM), cos, sin)[:, :, 0, :]
    y_a = dsa_attention(q, k, v, qi, ki, wi) @ w_oa
    y_b = spatial_gating(jax.nn.gelu(u, approximate=False), jax.nn.gelu(vg, approximate=False),
                         w_s, b_s, ln_v_g, ln_v_b) @ w_ob
    merged = jax.nn.sigmoid(ga) * y_a + jax.nn.sigmoid(gb) * y_b
    return merged @ w_out


def sq_relu_mlp(x, w1, w2):
    return jnp.square(jax.nn.relu(x @ w1)) @ w2


def setup_inputs(seed: int = 0) -> dict:
    key = jax.random.key(seed)
    ks = jax.random.split(key, 20)
    f32 = jnp.float32
    L = DEPTH

    def nrm(k, shape, scale):
        return jax.random.normal(k, shape, f32) * scale

    x = jax.random.normal(ks[0], (BATCH, SEQ, D_MODEL), f32)
    offset = jax.random.randint(ks[1], (BATCH, 1), 0, 1024, dtype=jnp.int32)
    positions = offset + jnp.arange(SEQ, dtype=jnp.int32)[None, :]
    w_in = nrm(ks[2], (L, D_MODEL, N_IN), D_MODEL ** -0.5)
    w_in = w_in.at[:, :, V_START:V_END].multiply(BETA)
    w_s = nrm(ks[3], (L, SGU_GROUPS, SGU_CHUNK, SGU_CHUNK), SGU_CHUNK ** -0.5)
    b_s = 1.0 + nrm(ks[4], (L, SGU_GROUPS, SGU_CHUNK), 0.1)
    ln_v_g = 1.0 + nrm(ks[5], (L, SGU_WIDTH), 0.02)
    ln_v_b = nrm(ks[6], (L, SGU_WIDTH), 0.02)
    w_oa = nrm(ks[7], (L, ATT_Q, D_MODEL), BETA * ATT_Q ** -0.5)
    w_ob = nrm(ks[8], (L, SGU_WIDTH, D_MODEL), BETA * SGU_WIDTH ** -0.5)
    w_out = nrm(ks[9], (L, D_MODEL, D_MODEL), BETA * D_MODEL ** -0.5)
    ln1_g = 1.0 + nrm(ks[10], (L, D_MODEL), 0.02)
    ln1_b = nrm(ks[11], (L, D_MODEL), 0.02)
    w_ff1 = nrm(ks[12], (L, D_MODEL, D_FF), BETA * D_MODEL ** -0.5)
    w_ff2 = nrm(ks[13], (L, D_FF, D_MODEL), BETA * D_FF ** -0.5)
    ln2_g = 1.0 + nrm(ks[14], (L, D_MODEL), 0.02)
    ln2_b = nrm(ks[15], (L, D_MODEL), 0.02)
    return {"x": x, "positions": positions, "w_in": w_in, "w_s": w_s, "b_s": b_s,
            "ln_v_g": ln_v_g, "ln_v_b": ln_v_b, "w_oa": w_oa, "w_ob": w_ob, "w_out": w_out,
            "ln1_g": ln1_g, "ln1_b": ln1_b, "w_ff1": w_ff1, "w_ff2": w_ff2,
            "ln2_g": ln2_g, "ln2_b": ln2_b}


def reference(x, positions, w_in, w_s, b_s, ln_v_g, ln_v_b, w_oa, w_ob, w_out,
              ln1_g, ln1_b, w_ff1, w_ff2, ln2_g, ln2_b):
    cos, sin = rope_tables(positions)
    for l in range(DEPTH):
        mix = hybrid_mixer(x, cos, sin, w_in[l], w_s[l], b_s[l], ln_v_g[l], ln_v_b[l],
                           w_oa[l], w_ob[l], w_out[l])
        x = layer_norm(ALPHA * x + mix, ln1_g[l], ln1_b[l])
        x = layer_norm(ALPHA * x + sq_relu_mlp(x, w_ff1[l], w_ff2[l]), ln2_g[l], ln2_b[l])
    return x
```

```cpp
#include <hip/hip_runtime.h>
#include <hip/hip_cooperative_groups.h>
#include <cstdio>
#include <cstdint>
#include <cmath>
#ifndef MK_DUP
#define MK_DUP 0
#endif
namespace pg8 {
#define PG8_LAS __attribute__((address_space(3)))
typedef unsigned short bf16_t;
typedef short bf16x8 __attribute__((ext_vector_type(8)));
typedef float f32x4 __attribute__((ext_vector_type(4)));
typedef unsigned u32x4 __attribute__((ext_vector_type(4)));
constexpr int BM = 256, BK = 64, HALF = 128, HTB = HALF * BK * 2  , STAGE_BYTES = 8 * HTB, NXCD = 8, WGM = 8;

__host__ __device__ __forceinline__ int lds_byte(int r, int c) { const int st = (r >> 4) * 2 + (c >> 5), rr = r & 15, cc = c & 31, ob = rr * 64 + cc * 2; return st * 1024 + (ob ^ (((ob >> 9) & 1) << 5)); }
__host__ __device__ __forceinline__ void stage_rc(int b, int& R, int& C) { const int st = b / 1024, sb = b % 1024, swz = sb ^ (((sb >> 9) & 1) << 5); R = (st >> 1) * 16 + swz / 64; C = (st & 1) * 32 + (swz % 64) / 2; }
__host__ __device__ __forceinline__ int perm32(int rho) { const int n = rho >> 4, i = rho & 15; return 8 * (i >> 2) + 4 * n + (i & 3); }

struct Unit { int pm, pn, kind; };
struct Gemm { const bf16_t *A0, *A1, *B0, *B1; int M, N, K; };

struct StaticOrder {
    int nM, nN, nwg, G, c;
    __host__ __device__ void init(int M, int N, int G_, int c_) { nM = M / BM; nN = N / BM; nwg = nM * nN; G = G_; c = c_; }
    __host__ __device__ bool next(int i, Unit& u) const {
        const long L = (long)i * G + c; if (L >= nwg) return false;
        int wgid = (int)L; { const int q = nwg / NXCD, r = nwg % NXCD, xcd = wgid % NXCD, off = wgid / NXCD; wgid = (xcd < r ? xcd * (q + 1) : r * (q + 1) + (xcd - r) * q) + off; }
        const int nig = WGM * nN, gid = wgid / nig, fm = gid * WGM, gsz = (nM - fm) < WGM ? (nM - fm) : WGM;
        u.pm = fm + ((wgid % nig) % gsz); u.pn = (wgid % nig) / gsz; u.kind = 0; return true;
    }
    __device__ __forceinline__ void a_ready(const Unit&) const {}
    __device__ __forceinline__ void done(const Unit&) const {}
};


struct DualOrder : StaticOrder {
    __host__ __device__ bool next(int i, Unit& u) const { if (!StaticOrder::next(i >> 1, u)) return false; u.kind = i & 1; return true; }
};

__device__ __forceinline__ unsigned cvt_pk_bf16(float lo, float hi) { unsigned r; asm volatile("v_cvt_pk_bf16_f32 %0, %1, %2" : "=v"(r) : "v"(lo), "v"(hi)); return r; }
typedef float f32x2 __attribute__((ext_vector_type(2)));
__device__ __forceinline__ f32x2 gelu_pk(f32x2 v) {
    const f32x2 av = __builtin_elementwise_abs(v), d = av * 0.2316418882f + 1.0f;
    f32x2 t; t.x = __builtin_amdgcn_rcpf(d.x); t.y = __builtin_amdgcn_rcpf(d.y);
    f32x2 q = t * 0.5307027145f + (-0.7265760135f); q = q * t + 0.7107068705f; q = q * t + (-0.142248368f); q = q * t + 0.127414796f; q = q * t;
    const f32x2 s = (v * v) * (-0.72134752044f);
    f32x2 e; e.x = __builtin_amdgcn_exp2f(s.x); e.y = __builtin_amdgcn_exp2f(s.y);
    const f32x2 m = v * (q * e), r = v - m;
    f32x2 o; o.x = v.x < 0.f ? m.x : r.x; o.y = v.y < 0.f ? m.y : r.y; return o;
}
__device__ __forceinline__ f32x4 gelu4(f32x4 v) { const f32x2 a = gelu_pk((f32x2){v[0], v[1]}), b = gelu_pk((f32x2){v[2], v[3]}); return (f32x4){a.x, a.y, b.x, b.y}; }
__device__ __forceinline__ u32x4 pack8(f32x4 v0, f32x4 v1) { u32x4 w; w.x = cvt_pk_bf16(v0[0], v0[1]); w.y = cvt_pk_bf16(v0[2], v0[3]); w.z = cvt_pk_bf16(v1[0], v1[1]); w.w = cvt_pk_bf16(v1[2], v1[3]); return w; }
__device__ __forceinline__ void unpack8(u32x4 w, f32x4& v0, f32x4& v1) {
    v0 = (f32x4){__uint_as_float(w.x << 16), __uint_as_float(w.x & 0xffff0000u), __uint_as_float(w.y << 16), __uint_as_float(w.y & 0xffff0000u)};
    v1 = (f32x4){__uint_as_float(w.z << 16), __uint_as_float(w.z & 0xffff0000u), __uint_as_float(w.w << 16), __uint_as_float(w.w & 0xffff0000u)}; }
__device__ __forceinline__ f32x4 sigm4(f32x4 v) { f32x4 o;
#pragma unroll
    for (int i = 0; i < 4; ++i) o[i] = __builtin_amdgcn_rcpf(1.0f + __builtin_amdgcn_exp2f(v[i] * -1.44269504089f));
    return o; }

constexpr size_t KV8_ELEMS = (size_t)32768 * 64;
struct EpiInProj {
    static constexpr bool PERM = true, AFTER_DRAIN = false, ACCUM = true;
    bf16_t *Q, *KV, *QI, *KI, *U, *VG, *GR, *GB; float* WI; const float* CS;
    __device__ __forceinline__ bool operator()(f32x4 (&acc)[2][2][4][2], const Unit& u, int wr, int wc, int fr, int fq) const {
        const int pn = u.pn, row0 = u.pm * BM + wr * 64 + fr;
        if (pn >= 8 && pn < 16) {
            const int col = 128 * (pn - 8) + 32 * wc + 8 * fq;
#pragma unroll
            for (int ai = 0; ai < 2; ++ai)
#pragma unroll
                for (int m = 0; m < 4; ++m) { const size_t off = (size_t)(row0 + ai * HALF + m * 16) * 1024 + col;
                    const f32x4 sa0 = sigm4(acc[ai][0][m][0]), sa1 = sigm4(acc[ai][0][m][1]), sb0 = sigm4(acc[ai][1][m][0]), sb1 = sigm4(acc[ai][1][m][1]);
                    f32x4 r0, r1;
#pragma unroll
                    for (int i = 0; i < 4; ++i) { r0[i] = sa0[i] * __builtin_amdgcn_rcpf(sb0[i]); r1[i] = sa1[i] * __builtin_amdgcn_rcpf(sb1[i]); }
                    *(u32x4*)(GR + off) = pack8(r0, r1); *(u32x4*)(GB + off) = pack8(sb0, sb1); }
            return false;
        }
        if (pn == 16) {
#pragma unroll
            for (int ai = 0; ai < 2; ++ai)
#pragma unroll
                for (int m = 0; m < 4; ++m) { const int row = row0 + ai * HALF + m * 16;
                    f32x4 v0 = acc[ai][0][m][0], v1 = acc[ai][0][m][1];
                    if (wc == 0 && fq < 2) { const f32x4 c4 = *(const f32x4*)(CS + (size_t)row * 16 + 4 * fq), s4 = *(const f32x4*)(CS + (size_t)row * 16 + 8 + 4 * fq);
                        const f32x4 a = v0 * c4 - v1 * s4, b = v1 * c4 + v0 * s4; v0 = a; v1 = b; }
                    if (wc < 2) *(u32x4*)(KI + (size_t)(row >> 4) * 1024 + wc * 512 + ((row & 15) + 16 * fq) * 8) = pack8(v0, v1);
                    if (wc == 2 && fq == 0) *(f32x4*)(WI + (size_t)row * 4) = v0; }
            return false;
        }
        bf16_t* base; int ldc, colt, ropeb; bool act;
        if (pn < 2)       { base = Q;  ldc = 512; colt = pn * 256;       ropeb = 3; act = false; }
        else if (pn == 2) { base = KV; ldc = 128; colt = 0;              ropeb = 1; act = false; }
        else if (pn == 3) { base = QI; ldc = 256; colt = 0;              ropeb = 3; act = false; }
        else if (pn < 6)  { base = U;  ldc = 512; colt = (pn - 4) * 256; ropeb = 0; act = true; }
        else              { base = VG; ldc = 512; colt = (pn - 6) * 256; ropeb = 0; act = true; }
        const int col0 = colt + wc * 32 + 8 * fq;
        const bool ropelane = ((wc & 1) == 0) && (fq < 2);
#pragma unroll
        for (int ai = 0; ai < 2; ++ai)
#pragma unroll
            for (int m = 0; m < 4; ++m) { const int row = row0 + ai * HALF + m * 16; bf16_t* rowp = base + (size_t)row * ldc + col0;
                f32x4 c4 = (f32x4){1.f, 1.f, 1.f, 1.f}, s4 = (f32x4){0.f, 0.f, 0.f, 0.f};
                if (ropeb && ropelane) { c4 = *(const f32x4*)(CS + (size_t)row * 16 + 4 * fq); s4 = *(const f32x4*)(CS + (size_t)row * 16 + 8 + 4 * fq); }
#pragma unroll
                for (int bj = 0; bj < 2; ++bj) { f32x4 v0 = acc[ai][bj][m][0], v1 = acc[ai][bj][m][1];
                    if (act) { v0 = gelu4(v0); v1 = gelu4(v1); }
                    if (((ropeb >> bj) & 1) && ropelane) { const f32x4 a = v0 * c4 - v1 * s4, b = v1 * c4 + v0 * s4; v0 = a; v1 = b; }
                    if (pn == 2) {
                        if (bj == 0) { int w0 = __builtin_amdgcn_cvt_pk_fp8_f32(v0[0], v0[1], 0, false); w0 = __builtin_amdgcn_cvt_pk_fp8_f32(v0[2], v0[3], w0, true);
                            int w1 = __builtin_amdgcn_cvt_pk_fp8_f32(v1[0], v1[1], 0, false); w1 = __builtin_amdgcn_cvt_pk_fp8_f32(v1[2], v1[3], w1, true);
                            typedef int i32x2 __attribute__((ext_vector_type(2)));
                            *(i32x2*)((unsigned char*)KV + (size_t)row * 256 + wc * 32 + 8 * fq) = (i32x2){w0, w1}; }
                        else { int w0 = __builtin_amdgcn_cvt_pk_fp8_f32(v0[0], v0[1], 0, false); w0 = __builtin_amdgcn_cvt_pk_fp8_f32(v0[2], v0[3], w0, true);
                            int w1 = __builtin_amdgcn_cvt_pk_fp8_f32(v1[0], v1[1], 0, false); w1 = __builtin_amdgcn_cvt_pk_fp8_f32(v1[2], v1[3], w1, true);
                            typedef int i32x2 __attribute__((ext_vector_type(2)));
                            *(i32x2*)((unsigned char*)KV + (size_t)row * 256 + 128 + wc * 32 + 8 * fq) = (i32x2){w0, w1}; }
                    } else
                    *(u32x4*)(rowp + bj * HALF) = pack8(v0, v1); } }
        return false;
    }
};
struct EpiDual {
    static constexpr bool PERM = true, AFTER_DRAIN = false, ACCUM = true;
    const bf16_t *GR, *GB; bf16_t* O;
    __device__ __forceinline__ bool operator()(f32x4 (&acc)[2][2][4][2], const Unit& u, int wr, int wc, int fr, int fq) const {
        const int row0 = u.pm * BM + wr * 64 + fr, col0 = u.pn * BM + wc * 32 + 8 * fq;
        const bf16_t* G = u.kind == 0 ? GR : GB;
#pragma unroll
        for (int ai = 0; ai < 2; ++ai)
#pragma unroll
            for (int m = 0; m < 4; ++m) { const size_t off = (size_t)(row0 + ai * HALF + m * 16) * 1024 + col0;
#pragma unroll
                for (int bj = 0; bj < 2; ++bj) { f32x4 g0, g1; unpack8(*(const u32x4*)(G + off + bj * HALF), g0, g1);
                    acc[ai][bj][m][0] = acc[ai][bj][m][0] * g0; acc[ai][bj][m][1] = acc[ai][bj][m][1] * g1;
                    if (u.kind == 1) *(u32x4*)(O + off + bj * HALF) = pack8(acc[ai][bj][m][0], acc[ai][bj][m][1]); } }
        return u.kind == 0;
    }
};
struct EpiResid {
    static constexpr bool PERM = false, AFTER_DRAIN = false, ACCUM = true;
    const float* base; float* out; int ldc; float alpha;
    __device__ __forceinline__ bool operator()(f32x4 (&acc)[2][2][4][2], const Unit& u, int wr, int wc, int fr, int fq) const {
        const int row0 = u.pm * BM + wr * 64 + fr, col0 = u.pn * BM + wc * 32 + 4 * fq;
#pragma unroll
        for (int ai = 0; ai < 2; ++ai)
#pragma unroll
            for (int m = 0; m < 4; ++m) { const size_t off = (size_t)(row0 + ai * HALF + m * 16) * ldc + col0;
#pragma unroll
                for (int bj = 0; bj < 2; ++bj)
#pragma unroll
                    for (int n = 0; n < 2; ++n) { const f32x4 b = *(const f32x4*)(base + off + bj * HALF + n * 16); *(f32x4*)(out + off + bj * HALF + n * 16) = b * alpha + acc[ai][bj][m][n]; } }
        return false;
    }
};
struct EpiRelu2 {
    static constexpr bool PERM = true, AFTER_DRAIN = false, ACCUM = false;
    bf16_t* O; int ldc;
    __device__ __forceinline__ bool operator()(f32x4 (&acc)[2][2][4][2], const Unit& u, int wr, int wc, int fr, int fq) const {
        const int row0 = u.pm * BM + wr * 64 + fr, col0 = u.pn * BM + wc * 32 + 8 * fq;
#pragma unroll
        for (int ai = 0; ai < 2; ++ai)
#pragma unroll
            for (int m = 0; m < 4; ++m) { bf16_t* rowp = O + (size_t)(row0 + ai * HALF + m * 16) * ldc + col0;
#pragma unroll
                for (int bj = 0; bj < 2; ++bj) { f32x4 v0 = acc[ai][bj][m][0], v1 = acc[ai][bj][m][1];
#pragma unroll
                    for (int i = 0; i < 4; ++i) { const float a = fmaxf(v0[i], 0.f), b = fmaxf(v1[i], 0.f); v0[i] = a * a; v1[i] = b * b; }
                    *(u32x4*)(rowp + bj * HALF) = pack8(v0, v1); } }
        return false;
    }
};

struct EpiResidLN {
    static constexpr bool PERM = false, AFTER_DRAIN = false, ACCUM = true;
    float* out; const float* st; const float* g; const float* b; int ldc; float alpha;
    __device__ __forceinline__ bool operator()(f32x4 (&acc)[2][2][4][2], const Unit& u, int wr, int wc, int fr, int fq) const {
        const int row0 = u.pm * BM + wr * 64 + fr, col0 = u.pn * BM + wc * 32 + 4 * fq;
#pragma unroll
        for (int ai = 0; ai < 2; ++ai)
#pragma unroll
            for (int m = 0; m < 4; ++m) { const int row = row0 + ai * HALF + m * 16; const size_t off = (size_t)row * ldc + col0;
                const f32x2 s2 = *(const f32x2*)(st + (size_t)row * 2); const float mr = s2.x * s2.y;
#pragma unroll
                for (int bj = 0; bj < 2; ++bj)
#pragma unroll
                    for (int n = 0; n < 2; ++n) { const int cc = col0 + bj * HALF + n * 16;
                        const f32x4 gg = *(const f32x4*)(g + cc), bb = *(const f32x4*)(b + cc), y = *(const f32x4*)(out + off + bj * HALF + n * 16);
                        const f32x4 x = (y * s2.y - mr) * gg + bb;
                        *(f32x4*)(out + off + bj * HALF + n * 16) = x * alpha + acc[ai][bj][m][n]; } }
        return false;
    }
};
template <class Epi, class Sched, bool ALIGN_EPI = false, bool SP2 = false>
__device__ __forceinline__ void gemm_phase(PG8_LAS unsigned char* lds, const Gemm g, const Sched& S, const Epi& E) {
    int tid = threadIdx.x; asm volatile("" : "+v"(tid));
    const int wid = __builtin_amdgcn_readfirstlane(tid >> 6), lane = tid & 63, wr = wid >> 2, wc = wid & 3, fr = lane & 15, fq = lane >> 4;
    const int K = g.K, nt = K / BK;
    unsigned voffA[2], voffB[2];
#pragma unroll
    for (int i = 0; i < 2; ++i) { int R, C; stage_rc(tid * 16 + i * 8192, R, C); const int Rb = Epi::PERM ? ((R & ~31) + perm32(R & 31)) : R;
        voffA[i] = (unsigned)(R * K + C) * 2u; voffB[i] = (unsigned)(Rb * K + C) * 2u; }
    const size_t kstep = (size_t)(BK * 2);
    const size_t hstep = (size_t)HALF * K * 2;
    const size_t tstep = 2 * hstep;
    const unsigned ldsw = (unsigned)wid * 1024u;
    const int aoff = lds_byte(wr * 64 + fr, fq * 8), boff = lds_byte(wc * 32 + fr, fq * 8);
#define PG8_SA(b, h) (((b) * 2 + (h)) * HTB)
#define PG8_SB(b, h) ((4 + (b) * 2 + (h)) * HTB)
#define PG8_STAGE(bufoff, gbase, voff) do { _Pragma("unroll") for (int _i = 0; _i < 2; ++_i) \
        __builtin_amdgcn_global_load_lds((const unsigned*)((const char*)(gbase) + (voff)[_i]), (PG8_LAS unsigned*)(lds + (bufoff) + ldsw + _i * 8192), 16, 0, 0); } while (0)
#define PG8_LDA(dst, b, h) do { _Pragma("unroll") for (int m = 0; m < 4; ++m) _Pragma("unroll") for (int k = 0; k < 2; ++k) dst[m][k] = *(const PG8_LAS bf16x8*)(lds + PG8_SA(b, h) + aoff + m * 2048 + k * 1024); } while (0)
#define PG8_LDB(dst, b, h) do { _Pragma("unroll") for (int n = 0; n < 2; ++n) _Pragma("unroll") for (int k = 0; k < 2; ++k) dst[n][k] = *(const PG8_LAS bf16x8*)(lds + PG8_SB(b, h) + boff + n * 2048 + k * 1024); } while (0)
#define PG8_MMA(ai, bj, At, Bt) do { __builtin_amdgcn_s_setprio(1); _Pragma("unroll") for (int m = 0; m < 4; ++m) _Pragma("unroll") for (int n = 0; n < 2; ++n) _Pragma("unroll") for (int k = 0; k < 2; ++k) \
        acc[ai][bj][m][n] = __builtin_amdgcn_mfma_f32_16x16x32_bf16(Bt[n][k], At[m][k], acc[ai][bj][m][n], 0, 0, 0); __builtin_amdgcn_s_setprio(0); } while (0)
#define PG8_WAIT_V(n) asm volatile("s_waitcnt vmcnt(" #n ")" ::: "memory")
#define PG8_WAIT_L(n) asm volatile("s_waitcnt lgkmcnt(" #n ")" ::: "memory")
#define PG8_BAR __builtin_amdgcn_s_barrier()
#define PG8_SCHED __builtin_amdgcn_sched_barrier(0)
    Unit cur, nxt; int ui = 0;
    if (!S.next(0, cur)) return;
    f32x4 acc[2][2][4][2];
#pragma unroll
    for (int a = 0; a < 2; ++a)
#pragma unroll
        for (int b = 0; b < 2; ++b)
#pragma unroll
            for (int m = 0; m < 4; ++m)
#pragma unroll
                for (int n = 0; n < 2; ++n) acc[a][b][m][n] = (f32x4){0.f, 0.f, 0.f, 0.f};
    bf16x8 At[4][2], B0[2][2], B1[2][2];
    const char* cA = (const char*)(cur.kind ? g.A1 : g.A0) + (size_t)cur.pm * tstep; const char* cB = (const char*)(cur.kind ? g.B1 : g.B0) + (size_t)cur.pn * tstep;
    S.a_ready(cur);
    if constexpr (SP2) {
        PG8_STAGE(PG8_SB(0, 0), cB, voffB); PG8_STAGE(PG8_SB(0, 1), cB + hstep, voffB); PG8_STAGE(PG8_SA(0, 0), cA, voffA); PG8_STAGE(PG8_SA(0, 1), cA + hstep, voffA);
        if (wr == 1) PG8_BAR;
        PG8_WAIT_V(2); PG8_BAR;
        PG8_STAGE(PG8_SB(1, 0), cB + kstep, voffB); PG8_STAGE(PG8_SA(1, 0), cA + kstep, voffA); PG8_STAGE(PG8_SB(1, 1), cB + hstep + kstep, voffB);
        PG8_WAIT_V(6); PG8_BAR;
    } else {
        PG8_STAGE(PG8_SB(0, 0), cB, voffB); PG8_STAGE(PG8_SA(0, 0), cA, voffA); PG8_STAGE(PG8_SB(0, 1), cB + hstep, voffB); PG8_STAGE(PG8_SA(0, 1), cA + hstep, voffA);
        if (wr == 1) PG8_BAR;
        PG8_WAIT_V(4); PG8_BAR;
        PG8_STAGE(PG8_SB(1, 0), cB + kstep, voffB); PG8_STAGE(PG8_SA(1, 0), cA + kstep, voffA); PG8_STAGE(PG8_SB(1, 1), cB + hstep + kstep, voffB);
        PG8_WAIT_V(6); PG8_BAR;
    }
    for (;;) {
        const bool has_next = S.next(ui + 1, nxt);
        const char* nA = has_next ? (const char*)(nxt.kind ? g.A1 : g.A0) + (size_t)nxt.pm * tstep : cA; const char* nB = has_next ? (const char*)(nxt.kind ? g.B1 : g.B0) + (size_t)nxt.pn * tstep : cB;
        for (int t = 0; t < nt; t += 2) {
            const bool last = (t == nt - 2);
            const char* a1 = cA + (size_t)(t + 1) * kstep;
            const char* a2 = last ? nA : cA + (size_t)(t + 2) * kstep; const char* b2 = last ? nB : cB + (size_t)(t + 2) * kstep;
            const char* a3 = a2 + kstep; const char* b3 = b2 + kstep;
            if (last && has_next) S.a_ready(nxt);
            if constexpr (SP2) {
            PG8_LDB(B0, 0, 0); PG8_LDB(B1, 0, 1); PG8_SCHED; PG8_LDA(At, 0, 0); PG8_STAGE(PG8_SA(1, 1), a1 + hstep, voffA);
            PG8_WAIT_V(8); PG8_WAIT_L(0); PG8_BAR; PG8_MMA(0, 0, At, B0); PG8_MMA(0, 1, At, B1); PG8_BAR; PG8_SCHED;
            PG8_LDA(At, 0, 1); PG8_STAGE(PG8_SB(0, 0), b2, voffB); PG8_STAGE(PG8_SB(0, 1), b2 + hstep, voffB); PG8_STAGE(PG8_SA(0, 0), a2, voffA);
            PG8_WAIT_V(8); PG8_WAIT_L(0); PG8_BAR; PG8_MMA(1, 0, At, B0); PG8_MMA(1, 1, At, B1); PG8_BAR; PG8_SCHED;
            PG8_LDB(B0, 1, 0); PG8_LDB(B1, 1, 1); PG8_SCHED; PG8_LDA(At, 1, 0); PG8_STAGE(PG8_SA(0, 1), a2 + hstep, voffA);
            PG8_WAIT_V(8); PG8_WAIT_L(0); PG8_BAR; PG8_MMA(0, 0, At, B0); PG8_MMA(0, 1, At, B1); PG8_BAR; PG8_SCHED;
            PG8_LDA(At, 1, 1); PG8_STAGE(PG8_SB(1, 0), b3, voffB); PG8_STAGE(PG8_SB(1, 1), b3 + hstep, voffB); PG8_STAGE(PG8_SA(1, 0), a3, voffA);
            PG8_WAIT_V(8); PG8_WAIT_L(0); PG8_BAR; PG8_MMA(1, 0, At, B0); PG8_MMA(1, 1, At, B1); PG8_BAR; PG8_SCHED;
            } else {
            PG8_LDB(B0, 0, 0); PG8_SCHED; PG8_LDA(At, 0, 0); PG8_STAGE(PG8_SA(1, 1), a1 + hstep, voffA);
            PG8_WAIT_L(8); PG8_BAR; PG8_WAIT_L(0); PG8_MMA(0, 0, At, B0); PG8_BAR; PG8_SCHED;
            PG8_LDB(B1, 0, 1); PG8_STAGE(PG8_SB(0, 0), b2, voffB);
            PG8_BAR; PG8_WAIT_L(0); PG8_MMA(0, 1, At, B1); PG8_BAR;
            PG8_LDA(At, 0, 1); PG8_STAGE(PG8_SA(0, 0), a2, voffA);
            PG8_BAR; PG8_WAIT_L(0); PG8_MMA(1, 0, At, B0); PG8_BAR; PG8_SCHED;
            PG8_STAGE(PG8_SB(0, 1), b2 + hstep, voffB);
            PG8_WAIT_V(6); PG8_BAR; PG8_MMA(1, 1, At, B1); PG8_BAR;
            PG8_LDB(B0, 1, 0); PG8_SCHED; PG8_LDA(At, 1, 0); PG8_STAGE(PG8_SA(0, 1), a2 + hstep, voffA);
            PG8_WAIT_L(8); PG8_BAR; PG8_WAIT_L(0); PG8_MMA(0, 0, At, B0); PG8_BAR; PG8_SCHED;
            PG8_LDB(B1, 1, 1); PG8_STAGE(PG8_SB(1, 0), b3, voffB);
            PG8_BAR; PG8_WAIT_L(0); PG8_MMA(0, 1, At, B1); PG8_BAR;
            PG8_LDA(At, 1, 1); PG8_STAGE(PG8_SA(1, 0), a3, voffA);
            PG8_BAR; PG8_WAIT_L(0); PG8_MMA(1, 0, At, B0); PG8_BAR; PG8_SCHED;
            PG8_STAGE(PG8_SB(1, 1), b3 + hstep, voffB);
            PG8_WAIT_V(6); PG8_BAR; PG8_MMA(1, 1, At, B1); PG8_BAR;
            }
        }
        if constexpr (ALIGN_EPI) { if (wr == 0) PG8_BAR; }
        bool keep = false;
        if constexpr (!Epi::AFTER_DRAIN) { if (MK_DUP == 31 && !Epi::ACCUM) (void)E(acc, cur, wr, wc, fr, fq); keep = E(acc, cur, wr, wc, fr, fq); S.done(cur); }
        if (!has_next) break;
        if (!keep) {
#pragma unroll
        for (int a = 0; a < 2; ++a)
#pragma unroll
            for (int b = 0; b < 2; ++b)
#pragma unroll
                for (int m = 0; m < 4; ++m)
#pragma unroll
                    for (int n = 0; n < 2; ++n) acc[a][b][m][n] = (f32x4){0.f, 0.f, 0.f, 0.f};
        }
        cur = nxt; cA = nA; cB = nB; ++ui;
        if constexpr (ALIGN_EPI) { if (wr == 1) PG8_BAR; }
    }
    PG8_WAIT_V(0);
    if constexpr (!ALIGN_EPI) { if (wr == 0) PG8_BAR; }
    PG8_BAR;
    if constexpr (Epi::AFTER_DRAIN) { E.fused(acc, cur, wr, wc, fr, fq, lds, wid, lane); S.done(cur); }
#undef PG8_SA
#undef PG8_SB
#undef PG8_STAGE
#undef PG8_LDA
#undef PG8_LDB
#undef PG8_MMA
#undef PG8_WAIT_V
#undef PG8_WAIT_L
#undef PG8_BAR
#undef PG8_SCHED
}
}

#define LAS __attribute__((address_space(3)))
#define GAS __attribute__((address_space(1)))
typedef unsigned short bf16;
typedef float f32x4 __attribute__((ext_vector_type(4)));
typedef float f32x2v __attribute__((ext_vector_type(2)));
typedef unsigned v4u __attribute__((ext_vector_type(4)));
typedef unsigned v2u __attribute__((ext_vector_type(2)));
typedef short bf16x8 __attribute__((ext_vector_type(8)));
typedef short s16x4 __attribute__((ext_vector_type(4)));
typedef GAS unsigned gu32;
#define RLX_AGENT __ATOMIC_RELAXED, __HIP_MEMORY_SCOPE_AGENT
#define LDS_WAIT() asm volatile("s_waitcnt lgkmcnt(0)" ::: "memory")
#define VM_WAIT() asm volatile("s_waitcnt vmcnt(0)" ::: "memory")

#ifndef MK_DUP
#define MK_DUP 0
#endif
#define REP(k) for (int rep_ = 0; rep_ < ((MK_DUP == (k)) ? 2 : 1); ++rep_)
#ifndef MK_NB
#define MK_NB 8
#endif
constexpr int NB = MK_NB, SEQ = 4096, M = NB * SEQ, D = 1024, FF = 4096, NINP = 4352, NIN = 4164, NLAYER = 2;
constexpr int NWAVES = 8, NTHREADS = 512;
constexpr float LN_EPS = 1e-5f, ALPHA = 1.4142135623730951f;
constexpr int C_Q = 0, C_K = 512, C_V = 640, C_QI = 768, C_KI = 1024, C_WI = 1088, C_U = 1092, C_VG = 1604, C_GA = 2116, C_GB = 3140;

constexpr size_t MiB = 1024 * 1024;
constexpr size_t WS_CTL = 0, CTL_ZERO_BYTES = 64 * 1024;
constexpr size_t WS_COS = 64 * 1024;
constexpr size_t WS_STAT = WS_COS + (size_t)M * 64;
constexpr size_t WS_WTRIL = WS_STAT + (size_t)M * 8;
constexpr size_t WS_WIN = WS_WTRIL + 2 * 4 * 128 * 128 * 2;
constexpr size_t WS_WOA = WS_WIN + (size_t)2 * NINP * D * 2;
constexpr size_t WS_WOB = WS_WOA + (size_t)2 * D * 512 * 2;
constexpr size_t WS_WOUT = WS_WOB + (size_t)2 * D * 512 * 2;
constexpr size_t WS_WFF1 = WS_WOUT + (size_t)2 * D * D * 2;
constexpr size_t WS_WFF2 = WS_WFF1 + (size_t)2 * FF * D * 2;
constexpr size_t WS_XB = WS_WFF2 + (size_t)2 * FF * D * 2;
constexpr size_t WS_ATT = WS_XB + (size_t)M * D * 2;
constexpr size_t WS_SGU = WS_ATT + (size_t)M * 512 * 2;
constexpr size_t WS_R1 = WS_SGU + (size_t)M * 512 * 2;
constexpr size_t WS_Q = WS_R1;
constexpr size_t WS_KV = WS_Q + (size_t)M * 512 * 2;
constexpr size_t WS_QI = WS_KV + (size_t)M * 256 * 2;
constexpr size_t WS_KI = WS_QI + (size_t)M * 256 * 2;
constexpr size_t WS_WI = WS_KI + (size_t)M * 64 * 2;
constexpr size_t WS_U = WS_WI + (size_t)M * 16;
constexpr size_t WS_VG = WS_U + (size_t)M * 512 * 2;
constexpr size_t WS_GR = WS_VG + (size_t)M * 512 * 2;
constexpr size_t WS_GB = WS_GR + (size_t)M * D * 2;
constexpr size_t WS_R1_END = WS_GB + (size_t)M * D * 2;
constexpr size_t WS_MERGED = WS_Q;
constexpr size_t WS_H = WS_R1;
constexpr size_t WS_END = (WS_R1_END > WS_H + (size_t)M * FF * 2) ? WS_R1_END : WS_H + (size_t)M * FF * 2;
static_assert(WS_MERGED + (size_t)M * D * 2 <= WS_KI, "merged overlay");

constexpr int RING_OFF = 0, RING_BYTES = 131072;
constexpr int LDSX_OFF = RING_BYTES;
constexpr int LDSCTL_OFF = RING_BYTES + 24576, MISC_OFF = LDSCTL_OFF + 320;
constexpr int LDS_BYTES = 156672;
static_assert(MISC_OFF + 128 <= LDS_BYTES, "LDS map");
constexpr int CW_TMO = 0, CW_BAR = 4096;

__device__ __forceinline__ unsigned f2bf(float f) { unsigned u = __builtin_bit_cast(unsigned, f); return (u + 0x7fffu + ((u >> 16) & 1u)) >> 16; }
__device__ __forceinline__ unsigned pk2(float lo, float hi) { return f2bf(lo) | (f2bf(hi) << 16); }
__device__ __forceinline__ float bf2f(unsigned short h) { return __uint_as_float((unsigned)h << 16); }
__device__ __forceinline__ float wave_sum(float v) {
#define WS_STEP(ctrl, rm) v += __uint_as_float((unsigned)__builtin_amdgcn_update_dpp(0, (int)__float_as_uint(v), ctrl, rm, 0xf, false));
    WS_STEP(0x111, 0xf) WS_STEP(0x112, 0xf) WS_STEP(0x114, 0xf) WS_STEP(0x118, 0xf) WS_STEP(0x142, 0xa) WS_STEP(0x143, 0xc)
#undef WS_STEP
    return __uint_as_float((unsigned)__builtin_amdgcn_readlane((int)__float_as_uint(v), 63));
}
__host__ __device__ __forceinline__ int perm16(int p) { return p < 16 ? ((p & 3) | ((p & 4) << 1) | ((p & 8) >> 1)) : p; }
__host__ __device__ __forceinline__ int colmap_in(int n) {
    const int tile = n >> 8, c = n & 255;
    if (tile < 2) return C_Q + (n & ~63) + perm16(n & 63);
    if (tile == 2) return c < 128 ? C_K + (c & ~63) + perm16(c & 63) : C_V + (c - 128);
    if (tile == 3) return C_QI + (c & ~63) + perm16(c & 63);
    if (tile < 6) return C_U + (n - 1024);
    if (tile < 8) return C_VG + (n - 1536);
    if (tile < 16) { const int j = tile - 8; return c < 128 ? C_GA + 128 * j + c : C_GB + 128 * j + (c - 128); }
    if (c < 64) return C_KI + perm16(c);
    if (c < 68) return C_WI + (c - 64);
    return -1;
}

#define XB_TMO      128
#define XB_XCNT(j)  (256  + 64 * (j))
#define XB_XSUB(j)  (1280 + 64 * (j))
#define XB_XGEN(j)  (2304 + 64 * (j))
#define XB_TOP      3328
#define XB_TOPGEN   3392
#define XCD_BAR_WORDS 3456
#define XB_SPIN_CAP (1u << 22)

__device__ __forceinline__ unsigned xb_ld(unsigned* p)              { return __hip_atomic_load(p, __ATOMIC_RELAXED, __HIP_MEMORY_SCOPE_AGENT); }
__device__ __forceinline__ unsigned xb_add(unsigned* p, unsigned v) { return __hip_atomic_fetch_add(p, v, __ATOMIC_RELAXED, __HIP_MEMORY_SCOPE_AGENT); }
__device__ __forceinline__ unsigned xb_xcc_id() { return (unsigned)__builtin_amdgcn_s_getreg((3 << 11) | 20) & 0xFu; }
#define XB_SPIN(cond, bar) do { unsigned _sp = 0; while (cond) { __builtin_amdgcn_s_sleep(1); \
    if ((++_sp & 255u) == 0u) { if (xb_ld(&(bar)[XB_TMO])) break; if (_sp > XB_SPIN_CAP) { atomicAdd(&(bar)[XB_TMO], 1u); break; } } } } while (0)

struct XcdBarrier { unsigned* bar; unsigned x; volatile LAS unsigned* st; };

__device__ __forceinline__ XcdBarrier xcd_barrier_post(unsigned* bar, volatile LAS unsigned* st) {
    XcdBarrier b; b.bar = bar; b.x = xb_xcc_id(); b.st = st;
    if (threadIdx.x == 0) (void)xb_add(&bar[XB_XCNT(b.x)], 1u);
    return b;
}
__device__ __forceinline__ void xcd_barrier_complete(unsigned* bar, unsigned x, unsigned& nloc, unsigned& nx) {
    const unsigned G = gridDim.x * gridDim.y * gridDim.z;
    unsigned sum, cnt, mine, sp = 0u;
    for (;;) {
        sum = 0u; cnt = 0u; mine = 0u;
#pragma unroll
        for (unsigned j = 0; j < 16; ++j) { const unsigned c = xb_ld(&bar[XB_XCNT(j)]); sum += c; cnt += (c > 0u) ? 1u : 0u; mine = (j == x) ? c : mine; }
        if (sum == G) break;
        __builtin_amdgcn_s_sleep(1);
        if ((++sp & 255u) == 0u) { if (xb_ld(&bar[XB_TMO])) break; if (sp > XB_SPIN_CAP) { atomicAdd(&bar[XB_TMO], 1u); break; } }
    }
    nloc = mine > 0u ? mine : 1u; nx = cnt > 0u ? cnt : 1u;
}
__device__ __forceinline__ void xcd_barrier(const XcdBarrier& b) {
    asm volatile("s_waitcnt vmcnt(0)" ::: "memory");
    __syncthreads();
    if (threadIdx.x == 0) {
        unsigned* bar = b.bar;
        __builtin_amdgcn_s_waitcnt(0);
        unsigned nloc = b.st[0], nx = b.st[1];
        if (nloc == 0u) { xcd_barrier_complete(bar, b.x, nloc, nx); b.st[0] = nloc; b.st[1] = nx; }
        const unsigned old = xb_add(&bar[XB_XSUB(b.x)], 1u);
        const unsigned gen = old / nloc;
        if (old + 1u == (gen + 1u) * nloc) {
            __builtin_amdgcn_fence(__ATOMIC_RELEASE, "agent");
            asm volatile("s_waitcnt vmcnt(0)" ::: "memory");
            const unsigned og = xb_add(&bar[XB_TOP], 1u);
            const unsigned tg = og / nx;
            if (og + 1u == (tg + 1u) * nx) xb_add(&bar[XB_TOPGEN], 1u);
            else XB_SPIN(xb_ld(&bar[XB_TOPGEN]) == tg, bar);
            __builtin_amdgcn_fence(__ATOMIC_ACQUIRE, "agent");
            xb_add(&bar[XB_XGEN(b.x)], 1u);
            asm volatile("s_waitcnt vmcnt(0)" ::: "memory");
        } else {
            XB_SPIN(xb_ld(&bar[XB_XGEN(b.x)]) == gen, bar);
            __builtin_amdgcn_fence(__ATOMIC_ACQUIRE, "agent");
            asm volatile("s_waitcnt vmcnt(0)" ::: "memory");
        }
    }
    __syncthreads();
}

struct Frame {
    LAS unsigned char* lds;
    int tid, lane, wave, vcu, G;
};

template <bool MAP>
__device__ __forceinline__ void p0_transpose_item(const float* W, int K, int ldw, int nblk, bf16* WT, LAS float* scr, int item, int lane) {
    const int kb = item / nblk, nb = item % nblk, k0 = 64 * kb, n0 = 32 * nb;
    const int src = MAP ? colmap_in(n0 + (lane & 31)) : n0 + (lane & 31);
    float wv[32];
#pragma unroll
    for (int i = 0; i < 32; ++i) { const int kk = 2 * i + (lane >> 5); wv[i] = (src >= 0) ? W[(size_t)(k0 + kk) * ldw + src] : 0.f; }
#pragma unroll
    for (int i = 0; i < 32; ++i) { const int kk = 2 * i + (lane >> 5); scr[kk * 33 + (lane & 31)] = wv[i]; }
    LDS_WAIT(); asm volatile("" ::: "memory");
    const int c = lane & 7;
#pragma unroll
    for (int j = 0; j < 4; ++j) { const int n = (lane >> 3) + 8 * j; const LAS float* s = scr + (8 * c) * 33 + n;
        v4u o; o.x = pk2(s[0 * 33], s[1 * 33]); o.y = pk2(s[2 * 33], s[3 * 33]); o.z = pk2(s[4 * 33], s[5 * 33]); o.w = pk2(s[6 * 33], s[7 * 33]);
        *(GAS v4u*)(WT + (size_t)(n0 + n) * K + k0 + 8 * c) = o; }
    LDS_WAIT(); asm volatile("" ::: "memory");
}
struct PArgs { const float* in[16]; float* out; unsigned char* ws; int ph_lo, ph_hi; };

__device__ __forceinline__ void p0_prologue(Frame F, const PArgs& a) {
    asm volatile("" : "+v"(F.lane)); asm volatile("" : "+v"(F.tid)); asm volatile("" : "+s"(F.wave));
    LAS float* scr = (LAS float*)(F.lds + RING_OFF + F.wave * 16384);
    const int gw = F.vcu * NWAVES + F.wave, NGW = F.G * NWAVES;
    constexpr int I_IN = (D / 64) * (NINP / 32), I_OA = (512 / 64) * (D / 32), I_OUT = (D / 64) * (D / 32), I_F1 = (D / 64) * (FF / 32), I_F2 = (FF / 64) * (D / 32);
    constexpr int PER_L = I_IN + 2 * I_OA + I_OUT + I_F1 + I_F2;
    for (int it = gw; it < NLAYER * PER_L; it += NGW) {
        const int l = it / PER_L; int r = it % PER_L;
        unsigned char* ws = a.ws;
        if (r < I_IN) { p0_transpose_item<true>(a.in[2] + (size_t)l * D * NIN, D, NIN, NINP / 32, (bf16*)(ws + WS_WIN) + (size_t)l * NINP * D, scr, r, F.lane); continue; } r -= I_IN;
        if (r < I_OA) { p0_transpose_item<false>(a.in[7] + (size_t)l * 512 * D, 512, D, D / 32, (bf16*)(ws + WS_WOA) + (size_t)l * D * 512, scr, r, F.lane); continue; } r -= I_OA;
        if (r < I_OA) { p0_transpose_item<false>(a.in[8] + (size_t)l * 512 * D, 512, D, D / 32, (bf16*)(ws + WS_WOB) + (size_t)l * D * 512, scr, r, F.lane); continue; } r -= I_OA;
        if (r < I_OUT) { p0_transpose_item<false>(a.in[9] + (size_t)l * D * D, D, D, D / 32, (bf16*)(ws + WS_WOUT) + (size_t)l * D * D, scr, r, F.lane); continue; } r -= I_OUT;
        if (r < I_F1) { p0_transpose_item<false>(a.in[12] + (size_t)l * D * FF, D, FF, FF / 32, (bf16*)(ws + WS_WFF1) + (size_t)l * FF * D, scr, r, F.lane); continue; } r -= I_F1;
        p0_transpose_item<false>(a.in[13] + (size_t)l * FF * D, FF, D, D / 32, (bf16*)(ws + WS_WFF2) + (size_t)l * D * FF, scr, r, F.lane);
    }
    for (int m0 = gw * 4; m0 < M; m0 += NGW * 4) {
        f32x4 v[4][4];
#pragma unroll
        for (int r = 0; r < 4; ++r) { const GAS f32x4* xr = (const GAS f32x4*)(a.in[0] + (size_t)(m0 + r) * D) + F.lane;
#pragma unroll
            for (int j = 0; j < 4; ++j) v[r][j] = xr[64 * j]; }
#pragma unroll
        for (int r = 0; r < 4; ++r) { GAS unsigned long long* o8 = (GAS unsigned long long*)((bf16*)(a.ws + WS_XB) + (size_t)(m0 + r) * D) + F.lane;
#pragma unroll
            for (int j = 0; j < 4; ++j) o8[64 * j] = (unsigned long long)pk2(v[r][j].x, v[r][j].y) | ((unsigned long long)pk2(v[r][j].z, v[r][j].w) << 32); }
    }
    const int gt = F.vcu * NTHREADS + F.tid, NGT = F.G * NTHREADS;
    const int* pos = (const int*)a.in[1];
    const float invf = (float)pow(500000.0, -(double)(gt & 7) / 8.0);
    for (int e = gt; e < M * 8; e += NGT) { const int m = e >> 3, i = e & 7;

        const float ang = (float)pos[m] * invf;
        float* cs = (float*)(a.ws + WS_COS) + (size_t)m * 16;
        cs[i] = (float)cos((double)ang); cs[8 + i] = (float)sin((double)ang); }
    for (int e = gt; e < NLAYER * 4 * 128 * 128; e += NGT) { const int s = e & 127, t = (e >> 7) & 127;
        ((bf16*)(a.ws + WS_WTRIL))[e] = (bf16)(s <= t ? f2bf(a.in[3][e]) : 0u); }
}

__device__ __forceinline__ void ln_row(const Frame& F, const float* yrow, const float* g, const float* b, float* xf, bf16* xb, float* st = nullptr) {
    const GAS f32x4* xr = (const GAS f32x4*)yrow + F.lane;
    f32x4 v[4]; float s = 0.f;
#pragma unroll
    for (int j = 0; j < 4; ++j) { v[j] = xr[64 * j]; s += (v[j].x + v[j].y) + (v[j].z + v[j].w); }
    const float mean = wave_sum(s) * (1.f / D); float s2 = 0.f;
#pragma unroll
    for (int j = 0; j < 4; ++j) { v[j] = v[j] - mean; s2 += (v[j].x * v[j].x + v[j].y * v[j].y) + (v[j].z * v[j].z + v[j].w * v[j].w); }
    const float rstd = 1.f / sqrtf(wave_sum(s2) * (1.f / D) + LN_EPS);
    if (st && F.lane == 0) { st[0] = mean; st[1] = rstd; }
#pragma unroll
    for (int j = 0; j < 4; ++j) { const f32x4 gg = ((const GAS f32x4*)g)[F.lane + 64 * j], bb = ((const GAS f32x4*)b)[F.lane + 64 * j];
        v[j] = v[j] * rstd * gg + bb;
        if (xf) ((GAS f32x4*)xf)[F.lane + 64 * j] = v[j];
        if (xb) ((GAS unsigned long long*)xb)[F.lane + 64 * j] = (unsigned long long)pk2(v[j].x, v[j].y) | ((unsigned long long)pk2(v[j].z, v[j].w) << 32); }
}
__device__ __forceinline__ void ln_phase(Frame F, float* y, const float* g, const float* b, bf16* xb, float* st) {
    asm volatile("" : "+v"(F.lane)); asm volatile("" : "+s"(F.wave));
    const int gw = F.vcu * NWAVES + F.wave, NGW = F.G * NWAVES;
    for (int m = gw; m < M; m += NGW) ln_row(F, y + (size_t)m * D, g, b, st ? nullptr : y + (size_t)m * D, xb ? xb + (size_t)m * D : nullptr, st ? st + (size_t)m * 2 : nullptr);
}

__device__ __forceinline__ void ln_phase_probe(Frame F, const float* y, const float* g, const float* b, bf16* xb) {
    asm volatile("" : "+v"(F.lane)); asm volatile("" : "+s"(F.wave));
    const int gw = F.vcu * NWAVES + F.wave, NGW = F.G * NWAVES;
    for (int m = gw; m < M; m += NGW) ln_row(F, y + (size_t)m * D, g, b, nullptr, xb + (size_t)m * D);
}
__device__ __forceinline__ int sgu_f(int s) { return 2 * ((s & 3) | (((s >> 3) & 1) << 2)); }
__device__ __forceinline__ s16x4 lds_tr16(LAS const void* p) { typedef short v4i16_t __attribute__((ext_vector_type(4)));
    return __builtin_bit_cast(s16x4, __builtin_amdgcn_ds_read_tr16_b64_v4i16((LAS v4i16_t*)p)); }

__device__ __forceinline__ void sgu_phase(const Frame& F, const bf16* VG, const bf16* U, const float* gv, const float* bv, const bf16* wtril, const float* bs, bf16* OUT) {
    typedef float f4 __attribute__((ext_vector_type(4)));
    int lane = F.lane; asm volatile("" : "+v"(lane)); int w = F.wave; asm volatile("" : "+s"(w));
    const int G = lane >> 4, li = lane & 15;
    LAS unsigned char* img = F.lds + RING_OFF;
    for (int c = F.vcu; c < M / 128; c += F.G) {
        const int t0 = c * 128;
        { f32x4 g0 = ((const GAS f32x4*)gv)[2 * lane], g1 = ((const GAS f32x4*)gv)[2 * lane + 1], b0 = ((const GAS f32x4*)bv)[2 * lane], b1 = ((const GAS f32x4*)bv)[2 * lane + 1];
          v4u rawv[16];
#pragma unroll
          for (int r = 0; r < 16; ++r) rawv[r] = *(const GAS v4u*)(VG + (size_t)(t0 + 16 * w + r) * 512 + 8 * lane);
#pragma unroll
          for (int r = 0; r < 16; ++r) { const int s = 16 * w + r;
            const v4u raw = rawv[r];
            f32x4 v0 = (f32x4){__uint_as_float(raw.x << 16), __uint_as_float(raw.x & 0xffff0000u), __uint_as_float(raw.y << 16), __uint_as_float(raw.y & 0xffff0000u)};
            f32x4 v1 = (f32x4){__uint_as_float(raw.z << 16), __uint_as_float(raw.z & 0xffff0000u), __uint_as_float(raw.w << 16), __uint_as_float(raw.w & 0xffff0000u)};
            const float mean = wave_sum((v0.x + v0.y) + (v0.z + v0.w) + (v1.x + v1.y) + (v1.z + v1.w)) * (1.f / 512.f);
            v0 = v0 - mean; v1 = v1 - mean;
            const float var = wave_sum((v0.x * v0.x + v0.y * v0.y) + (v0.z * v0.z + v0.w * v0.w) + (v1.x * v1.x + v1.y * v1.y) + (v1.z * v1.z + v1.w * v1.w)) * (1.f / 512.f);
            const float rstd = 1.f / sqrtf(var + LN_EPS);
            v0 = v0 * rstd * g0 + b0; v1 = v1 * rstd * g1 + b1;
            v4u o; o.x = pk2(v0.x, v0.y); o.y = pk2(v0.z, v0.w); o.z = pk2(v1.x, v1.y); o.w = pk2(v1.z, v1.w);
            *(LAS v4u*)(img + s * 1024 + ((lane ^ sgu_f(s)) << 4)) = o; }
        }
        LDS_WAIT(); __syncthreads();
        const int g = w >> 1, cbase = 64 * w;
        const bf16* wg = wtril + (size_t)g * 128 * 128;
        for (int tt = 0; tt < 8; ++tt) {
            f4 acc[4];
#pragma unroll
            for (int dt = 0; dt < 4; ++dt) acc[dt] = (f4){0.f, 0.f, 0.f, 0.f};
            const int nks = (tt >> 1) + 1;
            for (int ks = 0; ks < nks; ++ks) {
                const bf16x8 bw = *(const GAS bf16x8*)(wg + (size_t)(16 * tt + li) * 128 + 32 * ks + 8 * G);
                const int q = li >> 2, p = li & 3;
                const int s0 = 32 * ks + 8 * G + q, s1 = s0 + 4;
#pragma unroll
                for (int dt = 0; dt < 4; ++dt) { const int ch = cbase + 16 * dt + 4 * p;
                    const s16x4 a0 = lds_tr16(img + s0 * 1024 + (((ch >> 3) ^ sgu_f(s0)) << 4) + ((ch & 7) << 1));
                    const s16x4 a1 = lds_tr16(img + s1 * 1024 + (((ch >> 3) ^ sgu_f(s1)) << 4) + ((ch & 7) << 1));
                    const bf16x8 av = (bf16x8){a0[0], a0[1], a0[2], a0[3], a1[0], a1[1], a1[2], a1[3]};
                    acc[dt] = __builtin_amdgcn_mfma_f32_16x16x32_bf16(av, bw, acc[dt], 0, 0, 0); }
            }
            const int t = 16 * tt + li; const float bias = bs[g * 128 + t];
#pragma unroll
            for (int dt = 0; dt < 4; ++dt) { const int ch = cbase + 16 * dt + 4 * G; const size_t off = (size_t)(t0 + t) * 512 + ch;
                const v2u ur = *(const GAS v2u*)(U + off);
                const float u0 = __uint_as_float(ur.x << 16), u1 = __uint_as_float(ur.x & 0xffff0000u), u2 = __uint_as_float(ur.y << 16), u3 = __uint_as_float(ur.y & 0xffff0000u);
                v2u o; o.x = pk2(u0 * (acc[dt][0] + bias), u1 * (acc[dt][1] + bias)); o.y = pk2(u2 * (acc[dt][2] + bias), u3 * (acc[dt][3] + bias));
                *(GAS v2u*)(OUT + off) = o; }
        }
        __syncthreads();
    }
}

constexpr int DSA_LIST_OFF = LDSX_OFF;
static_assert(DSA_LIST_OFF + 4096 <= LDSCTL_OFF, "DSA LDS extras");
__device__ __forceinline__ unsigned mono_key(float f) { const unsigned u = __float_as_uint(f); return (u & 0x80000000u) ? ~u : (u | 0x80000000u); }
__device__ __forceinline__ unsigned mbcnt64(unsigned long long m) { return __builtin_amdgcn_mbcnt_hi((unsigned)(m >> 32), __builtin_amdgcn_mbcnt_lo((unsigned)m, 0u)); }
__device__ __forceinline__ unsigned wave_prefix_incl(unsigned v) {
    v += (unsigned)__builtin_amdgcn_update_dpp(0, (int)v, 0x111, 0xf, 0xf, false);
    v += (unsigned)__builtin_amdgcn_update_dpp(0, (int)v, 0x112, 0xf, 0xf, false);
    v += (unsigned)__builtin_amdgcn_update_dpp(0, (int)v, 0x114, 0xf, 0xf, false);
    v += (unsigned)__builtin_amdgcn_update_dpp(0, (int)v, 0x118, 0xf, 0xf, false);
    v += (unsigned)__builtin_amdgcn_update_dpp(0, (int)v, 0x142, 0xa, 0xf, false);
    v += (unsigned)__builtin_amdgcn_update_dpp(0, (int)v, 0x143, 0xc, 0xf, false);
    return v;
}
__device__ __forceinline__ unsigned rdlane(unsigned v, int l) { return (unsigned)__builtin_amdgcn_readlane((int)v, l); }
__device__ __forceinline__ void lds_inc(LAS unsigned* p) { (void)__hip_atomic_fetch_add(p, 1u, __ATOMIC_RELAXED, __HIP_MEMORY_SCOPE_WORKGROUP); }
__device__ __forceinline__ float xmax16(float x) { const auto r = __builtin_amdgcn_permlane16_swap(__float_as_uint(x), __float_as_uint(x), false, false); return fmaxf(__uint_as_float(r[0]), __uint_as_float(r[1])); }
__device__ __forceinline__ float xmax32(float x) { const auto r = __builtin_amdgcn_permlane32_swap(__float_as_uint(x), __float_as_uint(x), false, false); return fmaxf(__uint_as_float(r[0]), __uint_as_float(r[1])); }
__device__ __forceinline__ void glds16(const void* gsrc, unsigned lds_dst) {
    unsigned keep;
    asm volatile("s_mov_b32 %0, m0\n\ts_mov_b32 m0, %2\n\ts_nop 0\n\tglobal_load_lds_dwordx4 %1, off\n\ts_mov_b32 m0, %0" : "=&s"(keep) : "v"(gsrc), "s"(lds_dst) : "memory");
}

template <int PER>
__device__ __forceinline__ unsigned hist_find(LAS unsigned* h, int lane, unsigned& need, unsigned& cnt) {
    const int sb = 63 - lane; unsigned ssum = 0;
    if (PER == 64) {
#pragma unroll
        for (int i = 0; i < 16; ++i) { const v4u x = *(LAS v4u*)(h + 64 * sb + 4 * ((i + lane) & 15)); ssum += (x.x + x.y) + (x.z + x.w); }
    } else {
#pragma unroll
        for (int i = 0; i < 4; ++i) { const v4u x = *(LAS v4u*)(h + 16 * sb + 4 * ((i + (lane >> 2)) & 3)); ssum += (x.x + x.y) + (x.z + x.w); }
    }
    const unsigned incl = wave_prefix_incl(ssum), above = incl - ssum;
    const unsigned long long hm = __ballot(above < need && incl >= need);
    const int L = hm ? (int)__builtin_ctzll(hm) : 0;
    const unsigned aboveL = rdlane(above, L); const int SB = 63 - L;
    const unsigned c = (lane < PER) ? h[PER * SB + (PER - 1 - lane)] : 0u;
    const unsigned incl2 = wave_prefix_incl(c), above2 = aboveL + incl2 - c;
    const unsigned long long hm2 = __ballot(above2 < need && above2 + c >= need);
    const int L2 = hm2 ? (int)__builtin_ctzll(hm2) : 0;
    const unsigned bin = (unsigned)(PER * SB + (PER - 1 - L2));
    need = need - rdlane(above2, L2); cnt = rdlane(c, L2);
    return bin;
}

__device__ __forceinline__ void dsa_select(LAS float* row, LAS unsigned short* list, int N, int lane) {
    unsigned k[64];
    const int nblk = (N + 255) >> 8;
    const unsigned inval = (unsigned)lane << 20;
#pragma unroll
    for (int i = 0; i < 16; ++i) { if (i < nblk) { const f32x4 v = ((const LAS f32x4*)row)[64 * i + lane];
        if (256 * (i + 1) <= N) {
#pragma unroll
            for (int c = 0; c < 4; ++c) k[4 * i + c] = mono_key(v[c]);
        } else {
#pragma unroll
            for (int c = 0; c < 4; ++c) k[4 * i + c] = (256 * i + 4 * lane + c < N) ? mono_key(v[c]) : inval; } } }
    LDS_WAIT();
    LAS unsigned* hist = (LAS unsigned*)row;
#pragma unroll
    for (int i = 0; i < 16; ++i) ((LAS v4u*)row)[64 * i + lane] = (v4u){0u, 0u, 0u, 0u};
#pragma unroll
    for (int i = 0; i < 16; ++i) { if (i < nblk) {
#pragma unroll
        for (int c = 0; c < 4; ++c) lds_inc((LAS unsigned*)((LAS unsigned char*)hist + ((k[4 * i + c] >> 18) & 0x3ffcu))); } }
    LDS_WAIT();
    unsigned need = 256u, cB;
    const unsigned B = hist_find<64>(hist, lane, need, cB);
    unsigned thr, ties;
    if (cB <= 1024u) {
        LAS unsigned long long* buf = (LAS unsigned long long*)row;
        LAS unsigned* h2 = (LAS unsigned*)row + 2560;
        const unsigned lowkey = B << 20; unsigned nge = 0;
        const unsigned dummy = 10240u + 8u * (unsigned)lane;
        LDS_WAIT();
#pragma unroll
        for (int i = 0; i < 16; ++i) { if (i < nblk) {
            unsigned cnt = 0;
#pragma unroll
            for (int c = 0; c < 4; ++c) cnt += (k[4 * i + c] >= lowkey) ? 1u : 0u;
            const unsigned incl = wave_prefix_incl(cnt);
            unsigned off = (nge + incl - cnt) * 8u;
            nge += rdlane(incl, 63);
#pragma unroll
            for (int c = 0; c < 4; ++c) { const bool ge = k[4 * i + c] >= lowkey;
                *(LAS unsigned long long*)((LAS unsigned char*)row + (ge ? off : dummy)) = ((unsigned long long)k[4 * i + c] << 32) | (unsigned)(256 * i + 4 * lane + c);
                off += ge ? 8u : 0u; }
            if ((i & 3) == 3) __builtin_amdgcn_sched_barrier(0); } }
        LDS_WAIT();
#pragma unroll
        for (int i = 0; i < 4; ++i) ((LAS v4u*)h2)[64 * i + lane] = (v4u){0u, 0u, 0u, 0u};
        LDS_WAIT();
        for (unsigned e = lane; e < nge; e += 64) { const unsigned key = (unsigned)(buf[e] >> 32); if ((key >> 20) == B) lds_inc(h2 + ((key >> 10) & 1023u)); }
        LDS_WAIT();
        unsigned c2;
        const unsigned B2 = hist_find<16>(h2, lane, need, c2);
        const unsigned pre2 = (B << 10) | B2;
#pragma unroll
        for (int i = 0; i < 4; ++i) ((LAS v4u*)h2)[64 * i + lane] = (v4u){0u, 0u, 0u, 0u};
        LDS_WAIT();
        for (unsigned e = lane; e < nge; e += 64) { const unsigned key = (unsigned)(buf[e] >> 32); if ((key >> 10) == pre2) lds_inc(h2 + (key & 1023u)); }
        LDS_WAIT();
        unsigned c3;
        const unsigned B3 = hist_find<16>(h2, lane, need, c3);
        thr = (pre2 << 10) | B3; ties = need;
        unsigned out = 0, eqseen = 0;
        for (unsigned e0 = 0; e0 < nge; e0 += 64) { const unsigned e = e0 + lane; const bool valid = e < nge;
            const unsigned long long ent = valid ? buf[e] : 0ull; const unsigned key = (unsigned)(ent >> 32);
            const bool gt = valid && key > thr, eq = valid && key == thr;
            const unsigned long long meq = __ballot(eq);
            const bool take = gt || (eq && (eqseen + mbcnt64(meq) < ties)); eqseen += (unsigned)__builtin_popcountll(meq);
            const unsigned long long msel = __ballot(take);
            if (take) { const unsigned p = out + mbcnt64(msel); if (p < 256u) list[p] = (unsigned short)(unsigned)ent; }
            out += (unsigned)__builtin_popcountll(msel); }
    } else {
        LAS unsigned* kr = (LAS unsigned*)row;
        LDS_WAIT();
#pragma unroll
        for (int i = 0; i < 16; ++i) { v4u o;
#pragma unroll
            for (int c = 0; c < 4; ++c) o[c] = (i < nblk) ? k[4 * i + c] : 0u;
            ((LAS v4u*)kr)[64 * i + lane] = o; }
        LDS_WAIT();
        unsigned P = B << 20;
        for (int bit = 19; bit >= 0; --bit) { const unsigned trial = P | (1u << bit); unsigned c = 0;
#pragma unroll 4
            for (int j = 0; j < 64; ++j) c += (kr[64 * j + lane] >= trial) ? 1u : 0u;
            const unsigned tot = rdlane(wave_prefix_incl(c), 63);
            if (tot >= 256u) P = trial; }
        unsigned cgt = 0;
#pragma unroll 4
        for (int j = 0; j < 64; ++j) cgt += (kr[64 * j + lane] > P) ? 1u : 0u;
        thr = P; ties = 256u - rdlane(wave_prefix_incl(cgt), 63);
        unsigned out = 0, eqseen = 0;
#pragma unroll 2
        for (int j = 0; j < 64; ++j) { const unsigned kk = kr[64 * j + lane]; const bool gt = kk > thr, eq = kk == thr;
            const unsigned long long meq = __ballot(eq);
            const bool take = gt || (eq && (eqseen + mbcnt64(meq) < ties)); eqseen += (unsigned)__builtin_popcountll(meq);
            const unsigned long long msel = __ballot(take);
            if (take) { const unsigned p = out + mbcnt64(msel); if (p < 256u) list[p] = (unsigned short)(64 * j + lane); }
            out += (unsigned)__builtin_popcountll(msel); }
    }
}

__device__ __forceinline__ void dsa_phase(const Frame& F, const bf16* Q, const bf16* KV, const bf16* QI, const bf16* KI, const float* WI, bf16* ATT) {
    typedef float f4 __attribute__((ext_vector_type(4)));
    int lane = F.lane; asm volatile("" : "+v"(lane)); int w = F.wave; asm volatile("" : "+s"(w));
    LAS unsigned char* lds = F.lds;
    LAS float* sc = (LAS float*)(lds + RING_OFF);
    LAS unsigned short* list = (LAS unsigned short*)(lds + DSA_LIST_OFF) + w * 256;
    constexpr int CPB = 256 / NB, NPER = 512 / CPB;
    const int b = F.vcu / CPB, lc = F.vcu % CPB;
    for (int j = 0; j < NPER; ++j) {
        const int qb = j * CPB + ((j & 1) ? (CPB - 1 - lc) : lc);
        const size_t tb = (size_t)b * SEQ;
        const int q0 = 8 * qb;
        unsigned pf = 0u;
        if (j + 1 < NPER) { const int qbn = (j + 1) * CPB + (((j + 1) & 1) ? (CPB - 1 - lc) : lc); const size_t tn = tb + 8 * (size_t)qbn;
            if (w == 0 && lane < 32) pf = *(const GAS unsigned*)((const char*)(QI + tn * 256) + lane * 128);
            if (w == 1) pf = *(const GAS unsigned*)((const char*)(Q + tn * 512) + lane * 128);
            if (w == 2 && lane == 0) pf = *(const GAS unsigned*)(WI + tn * 4); }
        const int t = q0 + w, N = t + 1;
        const int nsel = N < 256 ? N : 256;
        LAS float* row = sc + w * 4096;
        REP(12) {
        if (rep_ > 0) { LDS_WAIT(); __syncthreads(); }
        REP(11) {
            int lane_s = lane; asm volatile("" : "+v"(lane_s)); const int G = lane_s >> 4, li = lane_s & 15;
            bf16x8 aq[2][2]; f4 wq[2];
#pragma unroll
            for (int rt = 0; rt < 2; ++rt) { const size_t tq = tb + q0 + 4 * rt + (li >> 2);
#pragma unroll
                for (int ks = 0; ks < 2; ++ks) aq[rt][ks] = *(const GAS bf16x8*)(QI + tq * 256 + (li & 3) * 64 + 32 * ks + 8 * G);
                wq[rt] = *(const GAS f4*)(WI + (tb + q0 + 4 * rt + G) * 4); }
            const int ntiles = (q0 + 8 + 15) >> 4;
            for (int tile0 = w; tile0 < ntiles; tile0 += 32) {
                bf16x8 bk[4][2];
#pragma unroll
                for (int u = 0; u < 4; ++u) { const int tile = tile0 + 8 * u;
                    if (tile < ntiles) { const bf16* kr = KI + ((tb >> 4) + tile) * 1024 + lane_s * 8; bk[u][0] = *(const GAS bf16x8*)kr; bk[u][1] = *(const GAS bf16x8*)(kr + 512); } }
#pragma unroll
                for (int u = 0; u < 4; ++u) { const int tile = tile0 + 8 * u;
                    if (tile < ntiles) {
#pragma unroll
                        for (int rt = 0; rt < 2; ++rt) { f4 c = (f4){0.f, 0.f, 0.f, 0.f};
                            c = __builtin_amdgcn_mfma_f32_16x16x32_bf16(aq[rt][0], bk[u][0], c, 0, 0, 0);
                            c = __builtin_amdgcn_mfma_f32_16x16x32_bf16(aq[rt][1], bk[u][1], c, 0, 0, 0);
                            float a = 0.f;
#pragma unroll
                            for (int h = 0; h < 4; ++h) a = fmaf(fmaxf(c[h], 0.f), wq[rt][h], a);
                            sc[(4 * rt + G) * 4096 + 16 * tile + li] = a; } } }
            }
        }
        LDS_WAIT(); __syncthreads();
        {
        if (N <= 256) {
#pragma unroll
            for (int i = 0; i < 4; ++i) list[64 * i + lane] = (unsigned short)((64 * i + lane) < N ? (64 * i + lane) : 0);
        } else { int lane_t = lane; asm volatile("" : "+v"(lane_t)); dsa_select(row, list, N, lane_t); }
        }
        }
        LDS_WAIT();
        REP(13) {
            int lane_a = lane; asm volatile("" : "+v"(lane_a)); const int G = lane_a >> 4, li = lane_a & 15;
            const size_t tq = tb + t;
            long qf[2][2];
#pragma unroll
            for (int g = 0; g < 2; ++g)
#pragma unroll
                for (int ks = 0; ks < 2; ++ks) { v4u raw = (v4u){0u, 0u, 0u, 0u};
                    if (li < 4) raw = *(const GAS v4u*)(Q + tq * 512 + (4 * g + li) * 64 + 32 * ks + 8 * G);
                    const float f0 = __uint_as_float(raw.x << 16), f1 = __uint_as_float(raw.x & 0xffff0000u), f2 = __uint_as_float(raw.y << 16), f3 = __uint_as_float(raw.y & 0xffff0000u);
                    const float f4_ = __uint_as_float(raw.z << 16), f5 = __uint_as_float(raw.z & 0xffff0000u), f6 = __uint_as_float(raw.w << 16), f7 = __uint_as_float(raw.w & 0xffff0000u);
                    int w0 = __builtin_amdgcn_cvt_pk_fp8_f32(f0, f1, 0, false); w0 = __builtin_amdgcn_cvt_pk_fp8_f32(f2, f3, w0, true);
                    int w1 = __builtin_amdgcn_cvt_pk_fp8_f32(f4_, f5, 0, false); w1 = __builtin_amdgcn_cvt_pk_fp8_f32(f6, f7, w1, true);
                    qf[g][ks] = (long)(((unsigned long long)(unsigned)w1 << 32) | (unsigned)w0); }
            asm volatile("" : "+v"(qf[0][0]), "+v"(qf[0][1]), "+v"(qf[1][0]), "+v"(qf[1][1]));
            f4 o[2][4]; float mrun[2], lrun[2];
#pragma unroll
            for (int g = 0; g < 2; ++g) { mrun[g] = -INFINITY; lrun[g] = 0.f;
#pragma unroll
                for (int dt = 0; dt < 4; ++dt) o[g][dt] = (f4){0.f, 0.f, 0.f, 0.f}; }
            LAS unsigned char* buf = (LAS unsigned char*)row;
            const unsigned bufaddr = (unsigned)__builtin_amdgcn_readfirstlane((int)(unsigned)(unsigned long)buf);
            const int nch = (nsel + 31) >> 5;
            const char* kvb = (const char*)KV + tb * 256;
            unsigned voff[8];
#pragma unroll
            for (int i = 0; i < 8; ++i) { const int slot = 4 * i + (lane_a >> 4); voff[i] = (unsigned)(((lane_a & 15) ^ ((slot & 15) ^ ((slot >> 4) << 3))) << 4); }
#define DSA_ISSUE(cc) do { unsigned kv_[8]; \
                _Pragma("unroll") for (int i = 0; i < 8; ++i) kv_[i] = list[32 * (cc) + 4 * i + (lane_a >> 4)]; \
                const unsigned dst_ = bufaddr + (unsigned)(((cc) & 1) * 8192); \
                _Pragma("unroll") for (int i = 0; i < 8; ++i) glds16(kvb + (size_t)kv_[i] * 256 + voff[i], dst_ + i * 1024); } while (0)
            DSA_ISSUE(0);
            for (int c = 0; c < nch; ++c) {
                LAS unsigned char* cb = buf + (c & 1) * 8192;
                if (c + 1 < nch) { DSA_ISSUE(c + 1); asm volatile("s_waitcnt vmcnt(8)" ::: "memory"); }
                else asm volatile("s_waitcnt vmcnt(0)" ::: "memory");
                long kf[2][2][2], vf[2][4];
#pragma unroll
                for (int T = 0; T < 2; ++T) { const int fs = li ^ (8 * T);
#pragma unroll
                    for (int g = 0; g < 2; ++g)
#pragma unroll
                        for (int ks = 0; ks < 2; ++ks) kf[T][g][ks] = *(const LAS long*)(cb + (16 * T + li) * 256 + (((g * 4 + ks * 2 + (G >> 1)) ^ fs) << 4) + ((G & 1) << 3)); }
                { const int q = li >> 1, p = li & 1, slot = (q < 4) ? (4 * G + q) : (16 + 4 * G + q - 4), fs = (slot & 15) ^ ((slot >> 4) << 3);
                  typedef int v2i_t __attribute__((ext_vector_type(2)));
#pragma unroll
                  for (int g = 0; g < 2; ++g)
#pragma unroll
                    for (int dt = 0; dt < 4; ++dt) { const v2i_t r_ = __builtin_amdgcn_ds_read_tr8_b64_v2i32((LAS v2i_t*)(cb + slot * 256 + (((8 + g * 4 + dt) ^ fs) << 4) + (p << 3)));
                        vf[g][dt] = (long)(((unsigned long long)(unsigned)r_[1] << 32) | (unsigned)r_[0]); } }
                LDS_WAIT();
                f4 s[2][2];
#pragma unroll
                for (int T = 0; T < 2; ++T)
#pragma unroll
                for (int g = 0; g < 2; ++g) { s[T][g] = (f4){0.f, 0.f, 0.f, 0.f};
                    s[T][g] = __builtin_amdgcn_mfma_f32_16x16x32_fp8_fp8(kf[T][g][0], qf[g][0], s[T][g], 0, 0, 0);
                    s[T][g] = __builtin_amdgcn_mfma_f32_16x16x32_fp8_fp8(kf[T][g][1], qf[g][1], s[T][g], 0, 0, 0); }
                float lmax[2];
#pragma unroll
                for (int g = 0; g < 2; ++g) {
#pragma unroll
                    for (int T = 0; T < 2; ++T) {
#pragma unroll
                        for (int r = 0; r < 4; ++r) s[T][g][r] *= 0.18033688011112042f;
                        if (32 * c + 32 > nsel) {
#pragma unroll
                            for (int r = 0; r < 4; ++r) if (32 * c + 16 * T + 4 * G + r >= nsel) s[T][g][r] = -INFINITY; } }
                    lmax[g] = fmaxf(fmaxf(fmaxf(s[0][g][0], s[0][g][1]), fmaxf(s[0][g][2], s[0][g][3])), fmaxf(fmaxf(s[1][g][0], s[1][g][1]), fmaxf(s[1][g][2], s[1][g][3]))); }
                if (__ballot(lmax[0] > mrun[0] + 8.f || lmax[1] > mrun[1] + 8.f)) {
#pragma unroll
                    for (int g = 0; g < 2; ++g) { const float cmax = xmax32(xmax16(lmax[g])); const float mnew = fmaxf(mrun[g], cmax);
                        const float alpha = __builtin_amdgcn_exp2f(mrun[g] - mnew); mrun[g] = mnew; lrun[g] *= alpha;
#pragma unroll
                        for (int dt = 0; dt < 4; ++dt) o[g][dt] = o[g][dt] * alpha; } }
#pragma unroll
                for (int g = 0; g < 2; ++g) { float p[8];
#pragma unroll
                    for (int T = 0; T < 2; ++T)
#pragma unroll
                        for (int r = 0; r < 4; ++r) p[4 * T + r] = __builtin_amdgcn_exp2f(s[T][g][r] - mrun[g]);
                    lrun[g] += ((p[0] + p[1]) + (p[2] + p[3])) + ((p[4] + p[5]) + (p[6] + p[7]));
                    int w0 = __builtin_amdgcn_cvt_pk_fp8_f32(p[0], p[1], 0, false); w0 = __builtin_amdgcn_cvt_pk_fp8_f32(p[2], p[3], w0, true);
                    int w1 = __builtin_amdgcn_cvt_pk_fp8_f32(p[4], p[5], 0, false); w1 = __builtin_amdgcn_cvt_pk_fp8_f32(p[6], p[7], w1, true);
                    const long pb = (long)(((unsigned long long)(unsigned)w1 << 32) | (unsigned)w0);
#pragma unroll
                    for (int dt = 0; dt < 4; ++dt) o[g][dt] = __builtin_amdgcn_mfma_f32_16x16x32_fp8_fp8(vf[g][dt], pb, o[g][dt], 0, 0, 0); }
            }
#undef DSA_ISSUE
#pragma unroll
            for (int g = 0; g < 2; ++g) { float l = lrun[g]; l += __shfl_xor(l, 16); l += __shfl_xor(l, 32); const float inv = 1.f / l;
                if (li < 4) {
#pragma unroll
                    for (int dt = 0; dt < 4; ++dt) { v2u ov; ov.x = pk2(o[g][dt][0] * inv, o[g][dt][1] * inv); ov.y = pk2(o[g][dt][2] * inv, o[g][dt][3] * inv);
                        *(GAS v2u*)(ATT + tq * 512 + (4 * g + li) * 64 + 16 * dt + 4 * G) = ov; } } }
        }
        asm volatile("" :: "v"(pf));
        VM_WAIT(); LDS_WAIT(); __syncthreads();
    }
}


#ifndef MK_N_LAUNCHES
#define MK_N_LAUNCHES 1
#endif
#ifndef MK_COOP
#define MK_COOP 1
#endif
constexpr int NPHASE = 1 + 8 * NLAYER;
__global__ void __launch_bounds__(NTHREADS, 2) mega_fwd(PArgs args) {
    extern __shared__ __attribute__((aligned(16))) unsigned char lds_raw[];
    Frame F;
    F.lds = (LAS unsigned char*)lds_raw;
    F.tid = threadIdx.x; F.lane = F.tid & 63; F.wave = __builtin_amdgcn_readfirstlane(F.tid >> 6);
    F.G = gridDim.x; { const int bx = blockIdx.x; F.vcu = (F.G % 8 == 0) ? (bx % 8) * (F.G / 8) + bx / 8 : bx; }
    gu32* ctl = (gu32*)(args.ws + WS_CTL);
    for (int u = F.tid; u < (LDS_BYTES - LDSCTL_OFF) / 4; u += NTHREADS) ((LAS unsigned*)(F.lds + LDSCTL_OFF))[u] = 0u;
    __syncthreads();
    const int lo = args.ph_lo, hi = args.ph_hi;
#if MK_COOP
    if (lo < 0) cooperative_groups::this_grid().sync();
#endif
    const bool use_bar = (hi - lo) > 1;
    XcdBarrier bar; bar.bar = (unsigned*)(ctl + CW_BAR); bar.x = 0; bar.st = nullptr;
    if (use_bar) bar = xcd_barrier_post((unsigned*)(ctl + CW_BAR), (volatile LAS unsigned*)(F.lds + MISC_OFF) + 8);
#define IN(k) (lo <= (k) && (k) < hi)
#define SEAM(k) do { if (IN((k) + 1)) { xcd_barrier(bar); if (MK_DUP == 10) xcd_barrier(bar); } } while (0)

#define ARGS_HERE const __attribute__((address_space(4))) PArgs* ap = (const __attribute__((address_space(4))) PArgs*)__builtin_amdgcn_kernarg_segment_ptr(); asm volatile("" : "+s"(ap)); unsigned char* ws = ap->ws;
#define SEAM0() SEAM(0)
    if (IN(0)) { ARGS_HERE; PArgs a2; for (int i = 0; i < 16; ++i) a2.in[i] = ap->in[i]; a2.out = ap->out; a2.ws = ws; REP(9) p0_prologue(F, a2); SEAM0(); }
#pragma unroll 1
    for (int l = 0; l < NLAYER; ++l) {
        const int pb = 1 + 8 * l;
        if (IN(pb + 0)) {
            ARGS_HERE; const bf16* XB = (const bf16*)(ws + WS_XB); const bf16* win = (const bf16*)(ws + WS_WIN) + (size_t)l * NINP * D;
            pg8::Gemm g{XB, XB, win, win, M, NINP, D}; pg8::StaticOrder S; S.init(M, NINP, F.G, (int)blockIdx.x);
            pg8::EpiInProj E{(bf16*)(ws + WS_Q), (bf16*)(ws + WS_KV), (bf16*)(ws + WS_QI), (bf16*)(ws + WS_KI), (bf16*)(ws + WS_U), (bf16*)(ws + WS_VG), (bf16*)(ws + WS_GR), (bf16*)(ws + WS_GB),
                             (float*)(ws + WS_WI), (const float*)(ws + WS_COS)};
            REP(1) pg8::gemm_phase<pg8::EpiInProj, pg8::StaticOrder, true, true>(F.lds + RING_OFF, g, S, E);
            SEAM(pb + 0);
        }
        if (IN(pb + 1)) {
            REP(2) { ARGS_HERE;
              sgu_phase(F, (const bf16*)(ws + WS_VG), (const bf16*)(ws + WS_U), ap->in[5] + (size_t)l * 512, ap->in[6] + (size_t)l * 512,
                        (const bf16*)(ws + WS_WTRIL) + (size_t)l * 4 * 128 * 128, ap->in[4] + (size_t)l * 4 * 128, (bf16*)(ws + WS_SGU)); }
            REP(3) { ARGS_HERE;
              dsa_phase(F, (const bf16*)(ws + WS_Q), (const bf16*)(ws + WS_KV), (const bf16*)(ws + WS_QI), (const bf16*)(ws + WS_KI), (const float*)(ws + WS_WI), (bf16*)(ws + WS_ATT)); }
            SEAM(pb + 1);
        }
        if (IN(pb + 2)) {
            ARGS_HERE; const bf16* woa = (const bf16*)(ws + WS_WOA) + (size_t)l * D * 512; const bf16* wob = (const bf16*)(ws + WS_WOB) + (size_t)l * D * 512;
            pg8::Gemm g{(const bf16*)(ws + WS_ATT), (const bf16*)(ws + WS_SGU), woa, wob, M, D, 512}; pg8::DualOrder S; S.init(M, D, F.G, (int)blockIdx.x);
            pg8::EpiDual E{(const bf16*)(ws + WS_GR), (const bf16*)(ws + WS_GB), (bf16*)(ws + WS_MERGED)};
            REP(4) pg8::gemm_phase<pg8::EpiDual, pg8::DualOrder, true, true>(F.lds + RING_OFF, g, S, E);
            SEAM(pb + 2);
        }
        if (IN(pb + 3)) {
            ARGS_HERE; const bf16* wout = (const bf16*)(ws + WS_WOUT) + (size_t)l * D * D;
            pg8::Gemm g{(const bf16*)(ws + WS_MERGED), (const bf16*)(ws + WS_MERGED), wout, wout, M, D, D}; pg8::StaticOrder S; S.init(M, D, F.G, (int)blockIdx.x);
            if (l == 0) { pg8::EpiResid E{ap->in[0], ap->out, D, ALPHA};
                for (int rep_ = 0; rep_ < ((MK_DUP == 5) ? 3 : 1); ++rep_) pg8::gemm_phase<pg8::EpiResid, pg8::StaticOrder, true, true>(F.lds + RING_OFF, g, S, E); }
            else { pg8::EpiResidLN E{ap->out, (const float*)(ws + WS_STAT), ap->in[14] + (size_t)(l - 1) * D, ap->in[15] + (size_t)(l - 1) * D, D, ALPHA};
                pg8::gemm_phase<pg8::EpiResidLN, pg8::StaticOrder, true, true>(F.lds + RING_OFF, g, S, E); }
            SEAM(pb + 3);
        }
        if (IN(pb + 4)) {
            ARGS_HERE;
            if (MK_DUP == 7) ln_phase_probe(F, ap->out, ap->in[10] + (size_t)l * D, ap->in[11] + (size_t)l * D, (bf16*)(ws + WS_ATT));
            ln_phase(F, ap->out, ap->in[10] + (size_t)l * D, ap->in[11] + (size_t)l * D, (bf16*)(ws + WS_XB), (float*)(ws + WS_STAT));
            SEAM(pb + 4);
        }
        if (IN(pb + 5)) {
            ARGS_HERE; const bf16* XB = (const bf16*)(ws + WS_XB); const bf16* wff1 = (const bf16*)(ws + WS_WFF1) + (size_t)l * FF * D;
            pg8::Gemm g{XB, XB, wff1, wff1, M, FF, D}; pg8::StaticOrder S; S.init(M, FF, F.G, (int)blockIdx.x);
            pg8::EpiRelu2 E{(bf16*)(ws + WS_H), FF};
            REP(6) pg8::gemm_phase<pg8::EpiRelu2, pg8::StaticOrder, true, true>(F.lds + RING_OFF, g, S, E);
            SEAM(pb + 5);
        }
        if (IN(pb + 6)) {
            ARGS_HERE; const bf16* wff2 = (const bf16*)(ws + WS_WFF2) + (size_t)l * D * FF;
            pg8::Gemm g{(const bf16*)(ws + WS_H), (const bf16*)(ws + WS_H), wff2, wff2, M, D, FF}; pg8::StaticOrder S; S.init(M, D, F.G, (int)blockIdx.x);
            pg8::EpiResidLN E{ap->out, (const float*)(ws + WS_STAT), ap->in[10] + (size_t)l * D, ap->in[11] + (size_t)l * D, D, ALPHA};
            pg8::gemm_phase<pg8::EpiResidLN, pg8::StaticOrder, true, true>(F.lds + RING_OFF, g, S, E);
            SEAM(pb + 6);
        }
        if (IN(pb + 7)) {
            ARGS_HERE;
            ln_phase(F, ap->out, ap->in[14] + (size_t)l * D, ap->in[15] + (size_t)l * D, l + 1 < NLAYER ? (bf16*)(ws + WS_XB) : nullptr, l + 1 < NLAYER ? (float*)(ws + WS_STAT) : nullptr);
            SEAM(pb + 7);
        }
    }
#undef IN
#undef SEAM
}

extern "C" void kernel_launch(void* const* d_in, const int* in_sizes, int n_in, void* d_out, int out_size, void* d_ws, size_t ws_size, hipStream_t stream) {
    static int grid = 0;
    if (grid == 0) {
        if (n_in != 16 || ws_size < WS_END) { fprintf(stderr, "kernel_launch: need 16 inputs and >= %zu bytes of workspace; got n_in %d, ws %zu; nothing launched\n", (size_t)WS_END, n_in, ws_size); grid = -1; return; }
        int dev = 0, cus = 0, per_cu = 0;
        if (hipGetDevice(&dev) != hipSuccess || hipDeviceGetAttribute(&cus, hipDeviceAttributeMultiprocessorCount, dev) != hipSuccess) { fprintf(stderr, "kernel_launch: device query failed\n"); grid = -1; return; }
        if (hipFuncSetAttribute((const void*)mega_fwd, hipFuncAttributeMaxDynamicSharedMemorySize, LDS_BYTES) != hipSuccess) { fprintf(stderr, "kernel_launch: hipFuncSetAttribute failed\n"); grid = -1; return; }
        if (hipOccupancyMaxActiveBlocksPerMultiprocessor(&per_cu, (const void*)mega_fwd, NTHREADS, LDS_BYTES) != hipSuccess || per_cu < 1) { fprintf(stderr, "kernel_launch: occupancy query reports %d blocks per CU for %d threads + %d B LDS; nothing launched\n", per_cu, NTHREADS, LDS_BYTES); grid = -1; return; }
        (void)hipGetLastError();
        if (cus != 256) { fprintf(stderr, "kernel_launch: built for 256 CUs, device has %d; nothing launched\n", cus); grid = -1; return; }
        grid = cus * (per_cu < 1 ? per_cu : 1);
    }
    if (grid < 0) return;
    if (hipMemsetAsync((char*)d_ws + WS_CTL, 0, CTL_ZERO_BYTES, stream) != hipSuccess) { fprintf(stderr, "kernel_launch: memset failed\n"); return; }
    PArgs a{};
    for (int i = 0; i < 16; ++i) a.in[i] = (const float*)d_in[i];
    a.out = (float*)d_out; a.ws = (unsigned char*)d_ws;
#if MK_N_LAUNCHES == 1
    a.ph_lo = 0; a.ph_hi = NPHASE;
#if MK_COOP
    { void* kargs[] = {(void*)&a}; const hipError_t ce = hipLaunchCooperativeKernel((const void*)mega_fwd, dim3(grid), dim3(NTHREADS), kargs, LDS_BYTES, stream);
      if (ce != hipSuccess) fprintf(stderr, "kernel_launch: cooperative launch failed: %s (grid %d)\n", hipGetErrorString(ce), grid); }
#else
    hipLaunchKernelGGL(mega_fwd, dim3(grid), dim3(NTHREADS), LDS_BYTES, stream, a);
#endif
#else
    for (int p = 0; p < NPHASE; ++p) { a.ph_lo = p; a.ph_hi = p + 1; hipLaunchKernelGGL(mega_fwd, dim3(grid), dim3(NTHREADS), LDS_BYTES, stream, a); }
#endif
    const hipError_t le = hipPeekAtLastError();
    if (le != hipSuccess) fprintf(stderr, "kernel_launch: launch failed: %s\n", hipGetErrorName(le));
}
```

```cpp
#include <hip/hip_runtime.h>
#include <hip/hip_cooperative_groups.h>
#include <cstdio>
#include <cstdint>
#include <cmath>
#ifndef MK_DUP
#define MK_DUP 0
#endif
namespace pg8 {
#define PG8_LAS __attribute__((address_space(3)))
typedef unsigned short bf16_t;
typedef short bf16x8 __attribute__((ext_vector_type(8)));
typedef float f32x4 __attribute__((ext_vector_type(4)));
typedef unsigned u32x4 __attribute__((ext_vector_type(4)));
constexpr int BM = 256, BK = 64, HALF = 128, HTB = HALF * BK * 2  , STAGE_BYTES = 8 * HTB, NXCD = 8, WGM = 8;

__host__ __device__ __forceinline__ int lds_byte(int r, int c) { const int st = (r >> 4) * 2 + (c >> 5), rr = r & 15, cc = c & 31, ob = rr * 64 + cc * 2; return st * 1024 + (ob ^ (((ob >> 9) & 1) << 5)); }
__host__ __device__ __forceinline__ void stage_rc(int b, int& R, int& C) { const int st = b / 1024, sb = b % 1024, swz = sb ^ (((sb >> 9) & 1) << 5); R = (st >> 1) * 16 + swz / 64; C = (st & 1) * 32 + (swz % 64) / 2; }
__host__ __device__ __forceinline__ int perm32(int rho) { const int n = rho >> 4, i = rho & 15; return 8 * (i >> 2) + 4 * n + (i & 3); }

struct Unit { int pm, pn, kind; };
struct Gemm { const bf16_t *A0, *A1, *B0, *B1; int M, N, K; };

struct StaticOrder {
    int nM, nN, nwg, G, c;
    __host__ __device__ void init(int M, int N, int G_, int c_) { nM = M / BM; nN = N / BM; nwg = nM * nN; G = G_; c = c_; }
    __host__ __device__ bool next(int i, Unit& u) const {
        const long L = (long)i * G + c; if (L >= nwg) return false;
        int wgid = (int)L; { const int q = nwg / NXCD, r = nwg % NXCD, xcd = wgid % NXCD, off = wgid / NXCD; wgid = (xcd < r ? xcd * (q + 1) : r * (q + 1) + (xcd - r) * q) + off; }
        const int nig = WGM * nN, gid = wgid / nig, fm = gid * WGM, gsz = (nM - fm) < WGM ? (nM - fm) : WGM;
        u.pm = fm + ((wgid % nig) % gsz); u.pn = (wgid % nig) / gsz; u.kind = 0; return true;
    }
    __device__ __forceinline__ void a_ready(const Unit&) const {}
    __device__ __forceinline__ void done(const Unit&) const {}
};


struct DualOrder : StaticOrder {
    __host__ __device__ bool next(int i, Unit& u) const { if (!StaticOrder::next(i >> 1, u)) return false; u.kind = i & 1; return true; }
};

__device__ __forceinline__ unsigned cvt_pk_bf16(float lo, float hi) { unsigned r; asm volatile("v_cvt_pk_bf16_f32 %0, %1, %2" : "=v"(r) : "v"(lo), "v"(hi)); return r; }
typedef float f32x2 __attribute__((ext_vector_type(2)));
__device__ __forceinline__ f32x2 gelu_pk(f32x2 v) {
    const f32x2 av = __builtin_elementwise_abs(v), d = av * 0.2316418882f + 1.0f;
    f32x2 t; t.x = __builtin_amdgcn_rcpf(d.x); t.y = __builtin_amdgcn_rcpf(d.y);
    f32x2 q = t * 0.5307027145f + (-0.7265760135f); q = q * t + 0.7107068705f; q = q * t + (-0.142248368f); q = q * t + 0.127414796f; q = q * t;
    const f32x2 s = (v * v) * (-0.72134752044f);
    f32x2 e; e.x = __builtin_amdgcn_exp2f(s.x); e.y = __builtin_amdgcn_exp2f(s.y);
    const f32x2 m = v * (q * e), r = v - m;
    f32x2 o; o.x = v.x < 0.f ? m.x : r.x; o.y = v.y < 0.f ? m.y : r.y; return o;
}
__device__ __forceinline__ f32x4 gelu4(f32x4 v) { const f32x2 a = gelu_pk((f32x2){v[0], v[1]}), b = gelu_pk((f32x2){v[2], v[3]}); return (f32x4){a.x, a.y, b.x, b.y}; }
__device__ __forceinline__ u32x4 pack8(f32x4 v0, f32x4 v1) { u32x4 w; w.x = cvt_pk_bf16(v0[0], v0[1]); w.y = cvt_pk_bf16(v0[2], v0[3]); w.z = cvt_pk_bf16(v1[0], v1[1]); w.w = cvt_pk_bf16(v1[2], v1[3]); return w; }
__device__ __forceinline__ void unpack8(u32x4 w, f32x4& v0, f32x4& v1) {
    v0 = (f32x4){__uint_as_float(w.x << 16), __uint_as_float(w.x & 0xffff0000u), __uint_as_float(w.y << 16), __uint_as_float(w.y & 0xffff0000u)};
    v1 = (f32x4){__uint_as_float(w.z << 16), __uint_as_float(w.z & 0xffff0000u), __uint_as_float(w.w << 16), __uint_as_float(w.w & 0xffff0000u)}; }
__device__ __forceinline__ f32x4 sigm4(f32x4 v) { f32x4 o;
#pragma unroll
    for (int i = 0; i < 4; ++i) o[i] = __builtin_amdgcn_rcpf(1.0f + __builtin_amdgcn_exp2f(v[i] * -1.44269504089f));
    return o; }

constexpr size_t KV8_ELEMS = (size_t)32768 * 64;
struct EpiInProj {
    static constexpr bool PERM = true, AFTER_DRAIN = false, ACCUM = true;
    bf16_t *Q, *KV, *QI, *KI, *U, *VG, *GR, *GB; float* WI; const float* CS;
    __device__ __forceinline__ bool operator()(f32x4 (&acc)[2][2][4][2], const Unit& u, int wr, int wc, int fr, int fq) const {
        const int pn = u.pn, row0 = u.pm * BM + wr * 64 + fr;
        if (pn >= 8 && pn < 16) {
            const int col = 128 * (pn - 8) + 32 * wc + 8 * fq;
#pragma unroll
            for (int ai = 0; ai < 2; ++ai)
#pragma unroll
                for (int m = 0; m < 4; ++m) { const size_t off = (size_t)(row0 + ai * HALF + m * 16) * 1024 + col;
                    const f32x4 sa0 = sigm4(acc[ai][0][m][0]), sa1 = sigm4(acc[ai][0][m][1]), sb0 = sigm4(acc[ai][1][m][0]), sb1 = sigm4(acc[ai][1][m][1]);
                    f32x4 r0, r1;
#pragma unroll
                    for (int i = 0; i < 4; ++i) { r0[i] = sa0[i] * __builtin_amdgcn_rcpf(sb0[i]); r1[i] = sa1[i] * __builtin_amdgcn_rcpf(sb1[i]); }
                    *(u32x4*)(GR + off) = pack8(r0, r1); *(u32x4*)(GB + off) = pack8(sb0, sb1); }
            return false;
        }
        if (pn == 16) {
#pragma unroll
            for (int ai = 0; ai < 2; ++ai)
#pragma unroll
                for (int m = 0; m < 4; ++m) { const int row = row0 + ai * HALF + m * 16;
                    f32x4 v0 = acc[ai][0][m][0], v1 = acc[ai][0][m][1];
                    if (wc == 0 && fq < 2) { const f32x4 c4 = *(const f32x4*)(CS + (size_t)row * 16 + 4 * fq), s4 = *(const f32x4*)(CS + (size_t)row * 16 + 8 + 4 * fq);
                        const f32x4 a = v0 * c4 - v1 * s4, b = v1 * c4 + v0 * s4; v0 = a; v1 = b; }
                    if (wc < 2) *(u32x4*)(KI + (size_t)(row >> 4) * 1024 + wc * 512 + ((row & 15) + 16 * fq) * 8) = pack8(v0, v1);
                    if (wc == 2 && fq == 0) *(f32x4*)(WI + (size_t)row * 4) = v0; }
            return false;
        }
        bf16_t* base; int ldc, colt, ropeb; bool act;
        if (pn < 2)       { base = Q;  ldc = 512; colt = pn * 256;       ropeb = 3; act = false; }
        else if (pn == 2) { base = KV; ldc = 128; colt = 0;              ropeb = 1; act = false; }
        else if (pn == 3) { base = QI; ldc = 256; colt = 0;              ropeb = 3; act = false; }
        else if (pn < 6)  { base = U;  ldc = 512; colt = (pn - 4) * 256; ropeb = 0; act = true; }
        else              { base = VG; ldc = 512; colt = (pn - 6) * 256; ropeb = 0; act = true; }
        const int col0 = colt + wc * 32 + 8 * fq;
        const bool ropelane = ((wc & 1) == 0) && (fq < 2);
#pragma unroll
        for (int ai = 0; ai < 2; ++ai)
#pragma unroll
            for (int m = 0; m < 4; ++m) { const int row = row0 + ai * HALF + m * 16; bf16_t* rowp = base + (size_t)row * ldc + col0;
                f32x4 c4 = (f32x4){1.f, 1.f, 1.f, 1.f}, s4 = (f32x4){0.f, 0.f, 0.f, 0.f};
                if (ropeb && ropelane) { c4 = *(const f32x4*)(CS + (size_t)row * 16 + 4 * fq); s4 = *(const f32x4*)(CS + (size_t)row * 16 + 8 + 4 * fq); }
#pragma unroll
                for (int bj = 0; bj < 2; ++bj) { f32x4 v0 = acc[ai][bj][m][0], v1 = acc[ai][bj][m][1];
                    if (act) { v0 = gelu4(v0); v1 = gelu4(v1); }
                    if (((ropeb >> bj) & 1) && ropelane) { const f32x4 a = v0 * c4 - v1 * s4, b = v1 * c4 + v0 * s4; v0 = a; v1 = b; }
                    if (pn == 2) {
                        if (bj == 0) { int w0 = __builtin_amdgcn_cvt_pk_fp8_f32(v0[0], v0[1], 0, false); w0 = __builtin_amdgcn_cvt_pk_fp8_f32(v0[2], v0[3], w0, true);
                            int w1 = __builtin_amdgcn_cvt_pk_fp8_f32(v1[0], v1[1], 0, false); w1 = __builtin_amdgcn_cvt_pk_fp8_f32(v1[2], v1[3], w1, true);
                            typedef int i32x2 __attribute__((ext_vector_type(2)));
                            *(i32x2*)((unsigned char*)KV + (size_t)row * 256 + wc * 32 + 8 * fq) = (i32x2){w0, w1}; }
                        else { int w0 = __builtin_amdgcn_cvt_pk_fp8_f32(v0[0], v0[1], 0, false); w0 = __builtin_amdgcn_cvt_pk_fp8_f32(v0[2], v0[3], w0, true);
                            int w1 = __builtin_amdgcn_cvt_pk_fp8_f32(v1[0], v1[1], 0, false); w1 = __builtin_amdgcn_cvt_pk_fp8_f32(v1[2], v1[3], w1, true);
                            typedef int i32x2 __attribute__((ext_vector_type(2)));
                            *(i32x2*)((unsigned char*)KV + (size_t)row * 256 + 128 + wc * 32 + 8 * fq) = (i32x2){w0, w1}; }
                    } else
                    *(u32x4*)(rowp + bj * HALF) = pack8(v0, v1); } }
        return false;
    }
};
struct EpiDual {
    static constexpr bool PERM = true, AFTER_DRAIN = false, ACCUM = true;
    const bf16_t *GR, *GB; bf16_t* O;
    __device__ __forceinline__ bool operator()(f32x4 (&acc)[2][2][4][2], const Unit& u, int wr, int wc, int fr, int fq) const {
        const int row0 = u.pm * BM + wr * 64 + fr, col0 = u.pn * BM + wc * 32 + 8 * fq;
        const bf16_t* G = u.kind == 0 ? GR : GB;
#pragma unroll
        for (int ai = 0; ai < 2; ++ai) {
            u32x4 gv[4][2];
#pragma unroll
            for (int m = 0; m < 4; ++m) { const size_t off = (size_t)(row0 + ai * HALF + m * 16) * 1024 + col0;
#pragma unroll
                for (int bj = 0; bj < 2; ++bj) gv[m][bj] = *(const u32x4*)(G + off + bj * HALF); }
#pragma unroll
            for (int m = 0; m < 4; ++m) { const size_t off = (size_t)(row0 + ai * HALF + m * 16) * 1024 + col0;
#pragma unroll
                for (int bj = 0; bj < 2; ++bj) { f32x4 g0, g1; unpack8(gv[m][bj], g0, g1);
                    acc[ai][bj][m][0] = acc[ai][bj][m][0] * g0; acc[ai][bj][m][1] = acc[ai][bj][m][1] * g1;
                    if (u.kind == 1) *(u32x4*)(O + off + bj * HALF) = pack8(acc[ai][bj][m][0], acc[ai][bj][m][1]); } }
        }
        return u.kind == 0;
    }
};
struct EpiResid {
    static constexpr bool PERM = false, AFTER_DRAIN = false, ACCUM = true;
    const float* base; float* out; int ldc; float alpha;
    __device__ __forceinline__ bool operator()(f32x4 (&acc)[2][2][4][2], const Unit& u, int wr, int wc, int fr, int fq) const {
        const int row0 = u.pm * BM + wr * 64 + fr, col0 = u.pn * BM + wc * 32 + 4 * fq;
#pragma unroll
        for (int ai = 0; ai < 2; ++ai)
#pragma unroll
          for (int mp = 0; mp < 2; ++mp) {
            f32x4 y[2][2][2];
#pragma unroll
            for (int mm = 0; mm < 2; ++mm) { const size_t off = (size_t)(row0 + ai * HALF + (2 * mp + mm) * 16) * ldc + col0;
#pragma unroll
                for (int bj = 0; bj < 2; ++bj)
#pragma unroll
                    for (int n = 0; n < 2; ++n) y[mm][bj][n] = *(const f32x4*)(base + off + bj * HALF + n * 16); }
#pragma unroll
            for (int mm = 0; mm < 2; ++mm) { const int m = 2 * mp + mm; const size_t off = (size_t)(row0 + ai * HALF + m * 16) * ldc + col0;
#pragma unroll
                for (int bj = 0; bj < 2; ++bj)
#pragma unroll
                    for (int n = 0; n < 2; ++n) *(f32x4*)(out + off + bj * HALF + n * 16) = y[mm][bj][n] * alpha + acc[ai][bj][m][n]; }
          }
        return false;
    }
};
struct EpiRelu2 {
    static constexpr bool PERM = true, AFTER_DRAIN = false, ACCUM = false;
    bf16_t* O; int ldc;
    __device__ __forceinline__ bool operator()(f32x4 (&acc)[2][2][4][2], const Unit& u, int wr, int wc, int fr, int fq) const {
        const int row0 = u.pm * BM + wr * 64 + fr, col0 = u.pn * BM + wc * 32 + 8 * fq;
#pragma unroll
        for (int ai = 0; ai < 2; ++ai)
#pragma unroll
            for (int m = 0; m < 4; ++m) { bf16_t* rowp = O + (size_t)(row0 + ai * HALF + m * 16) * ldc + col0;
#pragma unroll
                for (int bj = 0; bj < 2; ++bj) { f32x4 v0 = acc[ai][bj][m][0], v1 = acc[ai][bj][m][1];
#pragma unroll
                    for (int i = 0; i < 4; ++i) { const float a = fmaxf(v0[i], 0.f), b = fmaxf(v1[i], 0.f); v0[i] = a * a; v1[i] = b * b; }
                    *(u32x4*)(rowp + bj * HALF) = pack8(v0, v1); } }
        return false;
    }
};

struct EpiResidLN {
    static constexpr bool PERM = false, AFTER_DRAIN = false, ACCUM = true;
    float* out; const float* st; const float* g; const float* b; int ldc; float alpha;
    __device__ __forceinline__ bool operator()(f32x4 (&acc)[2][2][4][2], const Unit& u, int wr, int wc, int fr, int fq) const {
        const int row0 = u.pm * BM + wr * 64 + fr, col0 = u.pn * BM + wc * 32 + 4 * fq;
#pragma unroll
        for (int ai = 0; ai < 2; ++ai)
#pragma unroll
          for (int mp = 0; mp < 2; ++mp) {
            f32x4 y[2][2][2]; f32x2 s2[2];
#pragma unroll
            for (int mm = 0; mm < 2; ++mm) { const int row = row0 + ai * HALF + (2 * mp + mm) * 16; const size_t off = (size_t)row * ldc + col0;
                s2[mm] = *(const f32x2*)(st + (size_t)row * 2);
#pragma unroll
                for (int bj = 0; bj < 2; ++bj)
#pragma unroll
                    for (int n = 0; n < 2; ++n) y[mm][bj][n] = *(const f32x4*)(out + off + bj * HALF + n * 16); }
#pragma unroll
            for (int mm = 0; mm < 2; ++mm) { const int m = 2 * mp + mm; const int row = row0 + ai * HALF + m * 16; const size_t off = (size_t)row * ldc + col0; const float mr = s2[mm].x * s2[mm].y;
#pragma unroll
                for (int bj = 0; bj < 2; ++bj)
#pragma unroll
                    for (int n = 0; n < 2; ++n) { const int cc = col0 + bj * HALF + n * 16; const f32x4 gg = *(const f32x4*)(g + cc), bb = *(const f32x4*)(b + cc);
                        const f32x4 x = (y[mm][bj][n] * s2[mm].y - mr) * gg + bb;
                        *(f32x4*)(out + off + bj * HALF + n * 16) = x * alpha + acc[ai][bj][m][n]; } }
          }
        return false;
    }
};
template <class Epi, class Sched, bool ALIGN_EPI = false, bool SP2 = false>
__device__ __forceinline__ void gemm_phase(PG8_LAS unsigned char* lds, const Gemm g, const Sched& S, const Epi& E) {
    int tid = threadIdx.x; asm volatile("" : "+v"(tid));
    const int wid = __builtin_amdgcn_readfirstlane(tid >> 6), lane = tid & 63, wr = wid >> 2, wc = wid & 3, fr = lane & 15, fq = lane >> 4;
    const int K = g.K, nt = K / BK;
    unsigned voffA[2], voffB[2];
#pragma unroll
    for (int i = 0; i < 2; ++i) { int R, C; stage_rc(tid * 16 + i * 8192, R, C); const int Rb = Epi::PERM ? ((R & ~31) + perm32(R & 31)) : R;
        voffA[i] = (unsigned)(R * K + C) * 2u; voffB[i] = (unsigned)(Rb * K + C) * 2u; }
    const size_t kstep = (size_t)(BK * 2);
    const size_t hstep = (size_t)HALF * K * 2;
    const size_t tstep = 2 * hstep;
    const unsigned ldsw = (unsigned)wid * 1024u;
    const int aoff = lds_byte(wr * 64 + fr, fq * 8), boff = lds_byte(wc * 32 + fr, fq * 8);
#define PG8_SA(b, h) (((b) * 2 + (h)) * HTB)
#define PG8_SB(b, h) ((4 + (b) * 2 + (h)) * HTB)
#define PG8_STAGE(bufoff, gbase, voff) do { _Pragma("unroll") for (int _i = 0; _i < 2; ++_i) \
        __builtin_amdgcn_global_load_lds((const unsigned*)((const char*)(gbase) + (voff)[_i]), (PG8_LAS unsigned*)(lds + (bufoff) + ldsw + _i * 8192), 16, 0, 0); } while (0)
#define PG8_LDA(dst, b, h) do { _Pragma("unroll") for (int m = 0; m < 4; ++m) _Pragma("unroll") for (int k = 0; k < 2; ++k) dst[m][k] = *(const PG8_LAS bf16x8*)(lds + PG8_SA(b, h) + aoff + m * 2048 + k * 1024); } while (0)
#define PG8_LDB(dst, b, h) do { _Pragma("unroll") for (int n = 0; n < 2; ++n) _Pragma("unroll") for (int k = 0; k < 2; ++k) dst[n][k] = *(const PG8_LAS bf16x8*)(lds + PG8_SB(b, h) + boff + n * 2048 + k * 1024); } while (0)
#define PG8_MMA(ai, bj, At, Bt) do { __builtin_amdgcn_s_setprio(1); _Pragma("unroll") for (int m = 0; m < 4; ++m) _Pragma("unroll") for (int n = 0; n < 2; ++n) _Pragma("unroll") for (int k = 0; k < 2; ++k) \
        acc[ai][bj][m][n] = __builtin_amdgcn_mfma_f32_16x16x32_bf16(Bt[n][k], At[m][k], acc[ai][bj][m][n], 0, 0, 0); __builtin_amdgcn_s_setprio(0); } while (0)
#define PG8_WAIT_V(n) asm volatile("s_waitcnt vmcnt(" #n ")" ::: "memory")
#define PG8_WAIT_L(n) asm volatile("s_waitcnt lgkmcnt(" #n ")" ::: "memory")
#define PG8_BAR __builtin_amdgcn_s_barrier()
#define PG8_SCHED __builtin_amdgcn_sched_barrier(0)
    Unit cur, nxt; int ui = 0;
    if (!S.next(0, cur)) return;
    f32x4 acc[2][2][4][2];
#pragma unroll
    for (int a = 0; a < 2; ++a)
#pragma unroll
        for (int b = 0; b < 2; ++b)
#pragma unroll
            for (int m = 0; m < 4; ++m)
#pragma unroll
                for (int n = 0; n < 2; ++n) acc[a][b][m][n] = (f32x4){0.f, 0.f, 0.f, 0.f};
    bf16x8 At[4][2], B0[2][2], B1[2][2];
    const char* cA = (const char*)(cur.kind ? g.A1 : g.A0) + (size_t)cur.pm * tstep; const char* cB = (const char*)(cur.kind ? g.B1 : g.B0) + (size_t)cur.pn * tstep;
    S.a_ready(cur);
    if constexpr (SP2) {
        PG8_STAGE(PG8_SB(0, 0), cB, voffB); PG8_STAGE(PG8_SB(0, 1), cB + hstep, voffB); PG8_STAGE(PG8_SA(0, 0), cA, voffA); PG8_STAGE(PG8_SA(0, 1), cA + hstep, voffA);
        if (wr == 1) PG8_BAR;
        PG8_WAIT_V(2); PG8_BAR;
        PG8_STAGE(PG8_SB(1, 0), cB + kstep, voffB); PG8_STAGE(PG8_SA(1, 0), cA + kstep, voffA); PG8_STAGE(PG8_SB(1, 1), cB + hstep + kstep, voffB);
        PG8_WAIT_V(6); PG8_BAR;
    } else {
        PG8_STAGE(PG8_SB(0, 0), cB, voffB); PG8_STAGE(PG8_SA(0, 0), cA, voffA); PG8_STAGE(PG8_SB(0, 1), cB + hstep, voffB); PG8_STAGE(PG8_SA(0, 1), cA + hstep, voffA);
        if (wr == 1) PG8_BAR;
        PG8_WAIT_V(4); PG8_BAR;
        PG8_STAGE(PG8_SB(1, 0), cB + kstep, voffB); PG8_STAGE(PG8_SA(1, 0), cA + kstep, voffA); PG8_STAGE(PG8_SB(1, 1), cB + hstep + kstep, voffB);
        PG8_WAIT_V(6); PG8_BAR;
    }
    for (;;) {
        const bool has_next = S.next(ui + 1, nxt);
        const char* nA = has_next ? (const char*)(nxt.kind ? g.A1 : g.A0) + (size_t)nxt.pm * tstep : cA; const char* nB = has_next ? (const char*)(nxt.kind ? g.B1 : g.B0) + (size_t)nxt.pn * tstep : cB;
        for (int t = 0; t < nt; t += 2) {
            const bool last = (t == nt - 2);
            const char* a1 = cA + (size_t)(t + 1) * kstep;
            const char* a2 = last ? nA : cA + (size_t)(t + 2) * kstep; const char* b2 = last ? nB : cB + (size_t)(t + 2) * kstep;
            const char* a3 = a2 + kstep; const char* b3 = b2 + kstep;
            if (last && has_next) S.a_ready(nxt);
            if constexpr (SP2) {
            PG8_LDB(B0, 0, 0); PG8_LDB(B1, 0, 1); PG8_SCHED; PG8_LDA(At, 0, 0); PG8_STAGE(PG8_SA(1, 1), a1 + hstep, voffA);
            PG8_WAIT_V(8); PG8_WAIT_L(0); PG8_BAR; PG8_MMA(0, 0, At, B0); PG8_MMA(0, 1, At, B1); PG8_BAR; PG8_SCHED;
            PG8_LDA(At, 0, 1); PG8_STAGE(PG8_SB(0, 0), b2, voffB); PG8_STAGE(PG8_SB(0, 1), b2 + hstep, voffB); PG8_STAGE(PG8_SA(0, 0), a2, voffA);
            PG8_WAIT_V(8); PG8_WAIT_L(0); PG8_BAR; PG8_MMA(1, 0, At, B0); PG8_MMA(1, 1, At, B1); PG8_BAR; PG8_SCHED;
            PG8_LDB(B0, 1, 0); PG8_LDB(B1, 1, 1); PG8_SCHED; PG8_LDA(At, 1, 0); PG8_STAGE(PG8_SA(0, 1), a2 + hstep, voffA);
            PG8_WAIT_V(8); PG8_WAIT_L(0); PG8_BAR; PG8_MMA(0, 0, At, B0); PG8_MMA(0, 1, At, B1); PG8_BAR; PG8_SCHED;
            PG8_LDA(At, 1, 1); PG8_STAGE(PG8_SB(1, 0), b3, voffB); PG8_STAGE(PG8_SB(1, 1), b3 + hstep, voffB); PG8_STAGE(PG8_SA(1, 0), a3, voffA);
            PG8_WAIT_V(8); PG8_WAIT_L(0); PG8_BAR; PG8_MMA(1, 0, At, B0); PG8_MMA(1, 1, At, B1); PG8_BAR; PG8_SCHED;
            } else {
            PG8_LDB(B0, 0, 0); PG8_SCHED; PG8_LDA(At, 0, 0); PG8_STAGE(PG8_SA(1, 1), a1 + hstep, voffA);
            PG8_WAIT_L(8); PG8_BAR; PG8_WAIT_L(0); PG8_MMA(0, 0, At, B0); PG8_BAR; PG8_SCHED;
            PG8_LDB(B1, 0, 1); PG8_STAGE(PG8_SB(0, 0), b2, voffB);
            PG8_BAR; PG8_WAIT_L(0); PG8_MMA(0, 1, At, B1); PG8_BAR;
            PG8_LDA(At, 0, 1); PG8_STAGE(PG8_SA(0, 0), a2, voffA);
            PG8_BAR; PG8_WAIT_L(0); PG8_MMA(1, 0, At, B0); PG8_BAR; PG8_SCHED;
            PG8_STAGE(PG8_SB(0, 1), b2 + hstep, voffB);
            PG8_WAIT_V(6); PG8_BAR; PG8_MMA(1, 1, At, B1); PG8_BAR;
            PG8_LDB(B0, 1, 0); PG8_SCHED; PG8_LDA(At, 1, 0); PG8_STAGE(PG8_SA(0, 1), a2 + hstep, voffA);
            PG8_WAIT_L(8); PG8_BAR; PG8_WAIT_L(0); PG8_MMA(0, 0, At, B0); PG8_BAR; PG8_SCHED;
            PG8_LDB(B1, 1, 1); PG8_STAGE(PG8_SB(1, 0), b3, voffB);
            PG8_BAR; PG8_WAIT_L(0); PG8_MMA(0, 1, At, B1); PG8_BAR;
            PG8_LDA(At, 1, 1); PG8_STAGE(PG8_SA(1, 0), a3, voffA);
            PG8_BAR; PG8_WAIT_L(0); PG8_MMA(1, 0, At, B0); PG8_BAR; PG8_SCHED;
            PG8_STAGE(PG8_SB(1, 1), b3 + hstep, voffB);
            PG8_WAIT_V(6); PG8_BAR; PG8_MMA(1, 1, At, B1); PG8_BAR;
            }
        }
        if constexpr (ALIGN_EPI) { if (wr == 0) PG8_BAR; }
        bool keep = false;
        if constexpr (!Epi::AFTER_DRAIN) { if (MK_DUP == 31 && !Epi::ACCUM) (void)E(acc, cur, wr, wc, fr, fq); keep = E(acc, cur, wr, wc, fr, fq); S.done(cur); }
        if (!has_next) break;
        if (!keep) {
#pragma unroll
        for (int a = 0; a < 2; ++a)
#pragma unroll
            for (int b = 0; b < 2; ++b)
#pragma unroll
                for (int m = 0; m < 4; ++m)
#pragma unroll
                    for (int n = 0; n < 2; ++n) acc[a][b][m][n] = (f32x4){0.f, 0.f, 0.f, 0.f};
        }
        cur = nxt; cA = nA; cB = nB; ++ui;
        if constexpr (ALIGN_EPI) { if (wr == 1) PG8_BAR; }
    }
    PG8_WAIT_V(0);
    if constexpr (!ALIGN_EPI) { if (wr == 0) PG8_BAR; }
    PG8_BAR;
    if constexpr (Epi::AFTER_DRAIN) { E.fused(acc, cur, wr, wc, fr, fq, lds, wid, lane); S.done(cur); }
#undef PG8_SA
#undef PG8_SB
#undef PG8_STAGE
#undef PG8_LDA
#undef PG8_LDB
#undef PG8_MMA
#undef PG8_WAIT_V
#undef PG8_WAIT_L
#undef PG8_BAR
#undef PG8_SCHED
}
}

#define LAS __attribute__((address_space(3)))
#define GAS __attribute__((address_space(1)))
typedef unsigned short bf16;
typedef float f32x4 __attribute__((ext_vector_type(4)));
typedef float f32x2v __attribute__((ext_vector_type(2)));
typedef unsigned v4u __attribute__((ext_vector_type(4)));
typedef unsigned v2u __attribute__((ext_vector_type(2)));
typedef short bf16x8 __attribute__((ext_vector_type(8)));
typedef short s16x4 __attribute__((ext_vector_type(4)));
typedef GAS unsigned gu32;
#define RLX_AGENT __ATOMIC_RELAXED, __HIP_MEMORY_SCOPE_AGENT
#define LDS_WAIT() asm volatile("s_waitcnt lgkmcnt(0)" ::: "memory")
#define VM_WAIT() asm volatile("s_waitcnt vmcnt(0)" ::: "memory")

#ifndef MK_DUP
#define MK_DUP 0
#endif
#define REP(k) for (int rep_ = 0; rep_ < ((MK_DUP == (k)) ? 2 : 1); ++rep_)
#ifndef MK_NB
#define MK_NB 8
#endif
constexpr int NB = MK_NB, SEQ = 4096, M = NB * SEQ, D = 1024, FF = 4096, NINP = 4352, NIN = 4164, NLAYER = 2;
constexpr int NWAVES = 8, NTHREADS = 512;
constexpr float LN_EPS = 1e-5f, ALPHA = 1.4142135623730951f;
constexpr int C_Q = 0, C_K = 512, C_V = 640, C_QI = 768, C_KI = 1024, C_WI = 1088, C_U = 1092, C_VG = 1604, C_GA = 2116, C_GB = 3140;

constexpr size_t MiB = 1024 * 1024;
constexpr size_t WS_CTL = 0, CTL_ZERO_BYTES = 64 * 1024;
constexpr size_t WS_COS = 64 * 1024;
constexpr size_t WS_STAT = WS_COS + (size_t)M * 64;
constexpr size_t WS_WTRIL = WS_STAT + (size_t)M * 8;
constexpr size_t WS_WIN = WS_WTRIL + 2 * 4 * 128 * 128 * 2;
constexpr size_t WS_WOA = WS_WIN + (size_t)2 * NINP * D * 2;
constexpr size_t WS_WOB = WS_WOA + (size_t)2 * D * 512 * 2;
constexpr size_t WS_WOUT = WS_WOB + (size_t)2 * D * 512 * 2;
constexpr size_t WS_WFF1 = WS_WOUT + (size_t)2 * D * D * 2;
constexpr size_t WS_WFF2 = WS_WFF1 + (size_t)2 * FF * D * 2;
constexpr size_t WS_XB = WS_WFF2 + (size_t)2 * FF * D * 2;
constexpr size_t WS_ATT = WS_XB + (size_t)M * D * 2;
constexpr size_t WS_SGU = WS_ATT + (size_t)M * 512 * 2;
constexpr size_t WS_R1 = WS_SGU + (size_t)M * 512 * 2;
constexpr size_t WS_Q = WS_R1;
constexpr size_t WS_KV = WS_Q + (size_t)M * 512 * 2;
constexpr size_t WS_QI = WS_KV + (size_t)M * 256 * 2;
constexpr size_t WS_KI = WS_QI + (size_t)M * 256 * 2;
constexpr size_t WS_WI = WS_KI + (size_t)M * 64 * 2;
constexpr size_t WS_U = WS_WI + (size_t)M * 16;
constexpr size_t WS_VG = WS_U + (size_t)M * 512 * 2;
constexpr size_t WS_GR = WS_VG + (size_t)M * 512 * 2;
constexpr size_t WS_GB = WS_GR + (size_t)M * D * 2;
constexpr size_t WS_R1_END = WS_GB + (size_t)M * D * 2;
constexpr size_t WS_MERGED = WS_Q;
constexpr size_t WS_H = WS_R1;
constexpr size_t WS_END = (WS_R1_END > WS_H + (size_t)M * FF * 2) ? WS_R1_END : WS_H + (size_t)M * FF * 2;
static_assert(WS_MERGED + (size_t)M * D * 2 <= WS_KI, "merged overlay");

constexpr int RING_OFF = 0, RING_BYTES = 131072;
constexpr int LDSX_OFF = RING_BYTES;
constexpr int LDSCTL_OFF = RING_BYTES + 24576, MISC_OFF = LDSCTL_OFF + 320;
constexpr int LDS_BYTES = 156672;
static_assert(MISC_OFF + 128 <= LDS_BYTES, "LDS map");
constexpr int CW_TMO = 0, CW_BAR = 4096;

__device__ __forceinline__ unsigned f2bf(float f) { unsigned u = __builtin_bit_cast(unsigned, f); return (u + 0x7fffu + ((u >> 16) & 1u)) >> 16; }
__device__ __forceinline__ unsigned pk2(float lo, float hi) { return f2bf(lo) | (f2bf(hi) << 16); }
__device__ __forceinline__ float bf2f(unsigned short h) { return __uint_as_float((unsigned)h << 16); }
__device__ __forceinline__ float wave_sum(float v) {
#define WS_STEP(ctrl, rm) v += __uint_as_float((unsigned)__builtin_amdgcn_update_dpp(0, (int)__float_as_uint(v), ctrl, rm, 0xf, false));
    WS_STEP(0x111, 0xf) WS_STEP(0x112, 0xf) WS_STEP(0x114, 0xf) WS_STEP(0x118, 0xf) WS_STEP(0x142, 0xa) WS_STEP(0x143, 0xc)
#undef WS_STEP
    return __uint_as_float((unsigned)__builtin_amdgcn_readlane((int)__float_as_uint(v), 63));
}
__host__ __device__ __forceinline__ int perm16(int p) { return p < 16 ? ((p & 3) | ((p & 4) << 1) | ((p & 8) >> 1)) : p; }
__host__ __device__ __forceinline__ int colmap_in(int n) {
    const int tile = n >> 8, c = n & 255;
    if (tile < 2) return C_Q + (n & ~63) + perm16(n & 63);
    if (tile == 2) return c < 128 ? C_K + (c & ~63) + perm16(c & 63) : C_V + (c - 128);
    if (tile == 3) return C_QI + (c & ~63) + perm16(c & 63);
    if (tile < 6) return C_U + (n - 1024);
    if (tile < 8) return C_VG + (n - 1536);
    if (tile < 16) { const int j = tile - 8; return c < 128 ? C_GA + 128 * j + c : C_GB + 128 * j + (c - 128); }
    if (c < 64) return C_KI + perm16(c);
    if (c < 68) return C_WI + (c - 64);
    return -1;
}

#define XB_TMO      128
#define XB_XCNT(j)  (256  + 64 * (j))
#define XB_XSUB(j)  (1280 + 64 * (j))
#define XB_XGEN(j)  (2304 + 64 * (j))
#define XB_TOP      3328
#define XB_TOPGEN   3392
#define XCD_BAR_WORDS 3456
#define XB_SPIN_CAP (1u << 22)

__device__ __forceinline__ unsigned xb_ld(unsigned* p)              { return __hip_atomic_load(p, __ATOMIC_RELAXED, __HIP_MEMORY_SCOPE_AGENT); }
__device__ __forceinline__ unsigned xb_add(unsigned* p, unsigned v) { return __hip_atomic_fetch_add(p, v, __ATOMIC_RELAXED, __HIP_MEMORY_SCOPE_AGENT); }
__device__ __forceinline__ unsigned xb_xcc_id() { return (unsigned)__builtin_amdgcn_s_getreg((3 << 11) | 20) & 0xFu; }
#define XB_SPIN(cond, bar) do { unsigned _sp = 0; while (cond) { __builtin_amdgcn_s_sleep(1); \
    if ((++_sp & 255u) == 0u) { if (xb_ld(&(bar)[XB_TMO])) break; if (_sp > XB_SPIN_CAP) { atomicAdd(&(bar)[XB_TMO], 1u); break; } } } } while (0)

struct XcdBarrier { unsigned* bar; unsigned x; volatile LAS unsigned* st; };

__device__ __forceinline__ XcdBarrier xcd_barrier_post(unsigned* bar, volatile LAS unsigned* st) {
    XcdBarrier b; b.bar = bar; b.x = xb_xcc_id(); b.st = st;
    if (threadIdx.x == 0) (void)xb_add(&bar[XB_XCNT(b.x)], 1u);
    return b;
}
__device__ __forceinline__ void xcd_barrier_complete(unsigned* bar, unsigned x, unsigned& nloc, unsigned& nx) {
    const unsigned G = gridDim.x * gridDim.y * gridDim.z;
    unsigned sum, cnt, mine, sp = 0u;
    for (;;) {
        sum = 0u; cnt = 0u; mine = 0u;
#pragma unroll
        for (unsigned j = 0; j < 16; ++j) { const unsigned c = xb_ld(&bar[XB_XCNT(j)]); sum += c; cnt += (c > 0u) ? 1u : 0u; mine = (j == x) ? c : mine; }
        if (sum == G) break;
        __builtin_amdgcn_s_sleep(1);
        if ((++sp & 255u) == 0u) { if (xb_ld(&bar[XB_TMO])) break; if (sp > XB_SPIN_CAP) { atomicAdd(&bar[XB_TMO], 1u); break; } }
    }
    nloc = mine > 0u ? mine : 1u; nx = cnt > 0u ? cnt : 1u;
}
__device__ __forceinline__ void xcd_barrier(const XcdBarrier& b) {
    asm volatile("s_waitcnt vmcnt(0)" ::: "memory");
    __syncthreads();
    if (threadIdx.x == 0) {
        unsigned* bar = b.bar;
        __builtin_amdgcn_s_waitcnt(0);
        unsigned nloc = b.st[0], nx = b.st[1];
        if (nloc == 0u) { xcd_barrier_complete(bar, b.x, nloc, nx); b.st[0] = nloc; b.st[1] = nx; }
        const unsigned old = xb_add(&bar[XB_XSUB(b.x)], 1u);
        const unsigned gen = old / nloc;
        if (old + 1u == (gen + 1u) * nloc) {
            __builtin_amdgcn_fence(__ATOMIC_RELEASE, "agent");
            asm volatile("s_waitcnt vmcnt(0)" ::: "memory");
            const unsigned og = xb_add(&bar[XB_TOP], 1u);
            const unsigned tg = og / nx;
            if (og + 1u == (tg + 1u) * nx) xb_add(&bar[XB_TOPGEN], 1u);
            else XB_SPIN(xb_ld(&bar[XB_TOPGEN]) == tg, bar);
            __builtin_amdgcn_fence(__ATOMIC_ACQUIRE, "agent");
            xb_add(&bar[XB_XGEN(b.x)], 1u);
            asm volatile("s_waitcnt vmcnt(0)" ::: "memory");
        } else {
            XB_SPIN(xb_ld(&bar[XB_XGEN(b.x)]) == gen, bar);
            __builtin_amdgcn_fence(__ATOMIC_ACQUIRE, "agent");
            asm volatile("s_waitcnt vmcnt(0)" ::: "memory");
        }
    }
    __syncthreads();
}

struct Frame {
    LAS unsigned char* lds;
    int tid, lane, wave, vcu, G;
};

template <bool MAP>
__device__ __forceinline__ void p0_transpose_item(const float* W, int K, int ldw, int nblk, bf16* WT, LAS float* scr, int item, int lane) {
    const int kb = item / nblk, nb = item % nblk, k0 = 64 * kb, n0 = 32 * nb;
    const int src = MAP ? colmap_in(n0 + (lane & 31)) : n0 + (lane & 31);
    float wv[32];
#pragma unroll
    for (int i = 0; i < 32; ++i) { const int kk = 2 * i + (lane >> 5); wv[i] = (src >= 0) ? W[(size_t)(k0 + kk) * ldw + src] : 0.f; }
#pragma unroll
    for (int i = 0; i < 32; ++i) { const int kk = 2 * i + (lane >> 5); scr[kk * 33 + (lane & 31)] = wv[i]; }
    LDS_WAIT(); asm volatile("" ::: "memory");
    const int c = lane & 7;
#pragma unroll
    for (int j = 0; j < 4; ++j) { const int n = (lane >> 3) + 8 * j; const LAS float* s = scr + (8 * c) * 33 + n;
        v4u o; o.x = pk2(s[0 * 33], s[1 * 33]); o.y = pk2(s[2 * 33], s[3 * 33]); o.z = pk2(s[4 * 33], s[5 * 33]); o.w = pk2(s[6 * 33], s[7 * 33]);
        *(GAS v4u*)(WT + (size_t)(n0 + n) * K + k0 + 8 * c) = o; }
    LDS_WAIT(); asm volatile("" ::: "memory");
}
struct PArgs { const float* in[16]; float* out; unsigned char* ws; int ph_lo, ph_hi; };

__device__ __forceinline__ void p0_prologue(Frame F, const PArgs& a) {
    asm volatile("" : "+v"(F.lane)); asm volatile("" : "+v"(F.tid)); asm volatile("" : "+s"(F.wave));
    LAS float* scr = (LAS float*)(F.lds + RING_OFF + F.wave * 16384);
    const int gw = F.vcu * NWAVES + F.wave, NGW = F.G * NWAVES;
    constexpr int I_IN = (D / 64) * (NINP / 32), I_OA = (512 / 64) * (D / 32), I_OUT = (D / 64) * (D / 32), I_F1 = (D / 64) * (FF / 32), I_F2 = (FF / 64) * (D / 32);
    constexpr int PER_L = I_IN + 2 * I_OA + I_OUT + I_F1 + I_F2;
    for (int it = gw; it < NLAYER * PER_L; it += NGW) {
        const int l = it / PER_L; int r = it % PER_L;
        unsigned char* ws = a.ws;
        if (r < I_IN) { p0_transpose_item<true>(a.in[2] + (size_t)l * D * NIN, D, NIN, NINP / 32, (bf16*)(ws + WS_WIN) + (size_t)l * NINP * D, scr, r, F.lane); continue; } r -= I_IN;
        if (r < I_OA) { p0_transpose_item<false>(a.in[7] + (size_t)l * 512 * D, 512, D, D / 32, (bf16*)(ws + WS_WOA) + (size_t)l * D * 512, scr, r, F.lane); continue; } r -= I_OA;
        if (r < I_OA) { p0_transpose_item<false>(a.in[8] + (size_t)l * 512 * D, 512, D, D / 32, (bf16*)(ws + WS_WOB) + (size_t)l * D * 512, scr, r, F.lane); continue; } r -= I_OA;
        if (r < I_OUT) { p0_transpose_item<false>(a.in[9] + (size_t)l * D * D, D, D, D / 32, (bf16*)(ws + WS_WOUT) + (size_t)l * D * D, scr, r, F.lane); continue; } r -= I_OUT;
        if (r < I_F1) { p0_transpose_item<false>(a.in[12] + (size_t)l * D * FF, D, FF, FF / 32, (bf16*)(ws + WS_WFF1) + (size_t)l * FF * D, scr, r, F.lane); continue; } r -= I_F1;
        p0_transpose_item<false>(a.in[13] + (size_t)l * FF * D, FF, D, D / 32, (bf16*)(ws + WS_WFF2) + (size_t)l * D * FF, scr, r, F.lane);
    }
    for (int m0 = gw * 4; m0 < M; m0 += NGW * 4) {
        f32x4 v[4][4];
#pragma unroll
        for (int r = 0; r < 4; ++r) { const GAS f32x4* xr = (const GAS f32x4*)(a.in[0] + (size_t)(m0 + r) * D) + F.lane;
#pragma unroll
            for (int j = 0; j < 4; ++j) v[r][j] = xr[64 * j]; }
#pragma unroll
        for (int r = 0; r < 4; ++r) { GAS unsigned long long* o8 = (GAS unsigned long long*)((bf16*)(a.ws + WS_XB) + (size_t)(m0 + r) * D) + F.lane;
#pragma unroll
            for (int j = 0; j < 4; ++j) o8[64 * j] = (unsigned long long)pk2(v[r][j].x, v[r][j].y) | ((unsigned long long)pk2(v[r][j].z, v[r][j].w) << 32); }
    }
    const int gt = F.vcu * NTHREADS + F.tid, NGT = F.G * NTHREADS;
    const int* pos = (const int*)a.in[1];
    const float invf = (float)pow(500000.0, -(double)(gt & 7) / 8.0);
    for (int e = gt; e < M * 8; e += NGT) { const int m = e >> 3, i = e & 7;

        const float ang = (float)pos[m] * invf;
        float* cs = (float*)(a.ws + WS_COS) + (size_t)m * 16;
        cs[i] = (float)cos((double)ang); cs[8 + i] = (float)sin((double)ang); }
    for (int e = gt; e < NLAYER * 4 * 128 * 128; e += NGT) { const int s = e & 127, t = (e >> 7) & 127;
        ((bf16*)(a.ws + WS_WTRIL))[e] = (bf16)(s <= t ? f2bf(a.in[3][e]) : 0u); }
}

__device__ __forceinline__ void ln_row(const Frame& F, const float* yrow, const float* g, const float* b, float* xf, bf16* xb, float* st = nullptr) {
    const GAS f32x4* xr = (const GAS f32x4*)yrow + F.lane;
    f32x4 v[4]; float s = 0.f;
#pragma unroll
    for (int j = 0; j < 4; ++j) { v[j] = xr[64 * j]; s += (v[j].x + v[j].y) + (v[j].z + v[j].w); }
    const float mean = wave_sum(s) * (1.f / D); float s2 = 0.f;
#pragma unroll
    for (int j = 0; j < 4; ++j) { v[j] = v[j] - mean; s2 += (v[j].x * v[j].x + v[j].y * v[j].y) + (v[j].z * v[j].z + v[j].w * v[j].w); }
    const float rstd = 1.f / sqrtf(wave_sum(s2) * (1.f / D) + LN_EPS);
    if (st && F.lane == 0) { st[0] = mean; st[1] = rstd; }
#pragma unroll
    for (int j = 0; j < 4; ++j) { const f32x4 gg = ((const GAS f32x4*)g)[F.lane + 64 * j], bb = ((const GAS f32x4*)b)[F.lane + 64 * j];
        v[j] = v[j] * rstd * gg + bb;
        if (xf) ((GAS f32x4*)xf)[F.lane + 64 * j] = v[j];
        if (xb) ((GAS unsigned long long*)xb)[F.lane + 64 * j] = (unsigned long long)pk2(v[j].x, v[j].y) | ((unsigned long long)pk2(v[j].z, v[j].w) << 32); }
}
__device__ __forceinline__ void ln_phase(Frame F, float* y, const float* g, const float* b, bf16* xb, float* st) {
    asm volatile("" : "+v"(F.lane)); asm volatile("" : "+s"(F.wave));
    const int gw = F.vcu * NWAVES + F.wave, NGW = F.G * NWAVES;
    f32x4 gg[4], bb[4];
#pragma unroll
    for (int j = 0; j < 4; ++j) { gg[j] = ((const GAS f32x4*)g)[F.lane + 64 * j]; bb[j] = ((const GAS f32x4*)b)[F.lane + 64 * j]; }
    for (int m0 = 2 * gw; m0 < M; m0 += 2 * NGW) {
        f32x4 v[2][4];
#pragma unroll
        for (int r = 0; r < 2; ++r)
#pragma unroll
            for (int j = 0; j < 4; ++j) v[r][j] = ((const GAS f32x4*)(y + (size_t)(m0 + r) * D))[F.lane + 64 * j];
#pragma unroll
        for (int r = 0; r < 2; ++r) { const int m = m0 + r; float s = 0.f;
#pragma unroll
            for (int j = 0; j < 4; ++j) s += (v[r][j].x + v[r][j].y) + (v[r][j].z + v[r][j].w);
            const float mean = wave_sum(s) * (1.f / D); float s2 = 0.f;
#pragma unroll
            for (int j = 0; j < 4; ++j) { v[r][j] = v[r][j] - mean; s2 += (v[r][j].x * v[r][j].x + v[r][j].y * v[r][j].y) + (v[r][j].z * v[r][j].z + v[r][j].w * v[r][j].w); }
            const float rstd = 1.f / sqrtf(wave_sum(s2) * (1.f / D) + LN_EPS);
            if (st && F.lane == 0) { st[(size_t)m * 2] = mean; st[(size_t)m * 2 + 1] = rstd; }
#pragma unroll
            for (int j = 0; j < 4; ++j) { const f32x4 o = v[r][j] * rstd * gg[j] + bb[j];
                if (!st) ((GAS f32x4*)(y + (size_t)m * D))[F.lane + 64 * j] = o;
                if (xb) ((GAS unsigned long long*)(xb + (size_t)m * D))[F.lane + 64 * j] = (unsigned long long)pk2(o.x, o.y) | ((unsigned long long)pk2(o.z, o.w) << 32); } }
    }
}
__device__ __forceinline__ void ln_phase_probe(Frame F, const float* y, const float* g, const float* b, bf16* xb) {
    asm volatile("" : "+v"(F.lane)); asm volatile("" : "+s"(F.wave));
    const int gw = F.vcu * NWAVES + F.wave, NGW = F.G * NWAVES;
    for (int m = gw; m < M; m += NGW) ln_row(F, y + (size_t)m * D, g, b, nullptr, xb + (size_t)m * D);
}
__device__ __forceinline__ int sgu_f(int s) { return 2 * ((s & 3) | (((s >> 3) & 1) << 2)); }
__device__ __forceinline__ s16x4 lds_tr16(LAS const void* p) { typedef short v4i16_t __attribute__((ext_vector_type(4)));
    return __builtin_bit_cast(s16x4, __builtin_amdgcn_ds_read_tr16_b64_v4i16((LAS v4i16_t*)p)); }

__device__ __forceinline__ void sgu_phase(const Frame& F, const bf16* VG, const bf16* U, const float* gv, const float* bv, const bf16* wtril, const float* bs, bf16* OUT) {
    typedef float f4 __attribute__((ext_vector_type(4)));
    int lane = F.lane; asm volatile("" : "+v"(lane)); int w = F.wave; asm volatile("" : "+s"(w));
    const int G = lane >> 4, li = lane & 15;
    LAS unsigned char* img = F.lds + RING_OFF;
    for (int c = F.vcu; c < M / 128; c += F.G) {
        const int t0 = c * 128;
        { f32x4 g0 = ((const GAS f32x4*)gv)[2 * lane], g1 = ((const GAS f32x4*)gv)[2 * lane + 1], b0 = ((const GAS f32x4*)bv)[2 * lane], b1 = ((const GAS f32x4*)bv)[2 * lane + 1];
          v4u rawv[16];
#pragma unroll
          for (int r = 0; r < 16; ++r) rawv[r] = *(const GAS v4u*)(VG + (size_t)(t0 + 16 * w + r) * 512 + 8 * lane);
#pragma unroll
          for (int r = 0; r < 16; ++r) { const int s = 16 * w + r;
            const v4u raw = rawv[r];
            f32x4 v0 = (f32x4){__uint_as_float(raw.x << 16), __uint_as_float(raw.x & 0xffff0000u), __uint_as_float(raw.y << 16), __uint_as_float(raw.y & 0xffff0000u)};
            f32x4 v1 = (f32x4){__uint_as_float(raw.z << 16), __uint_as_float(raw.z & 0xffff0000u), __uint_as_float(raw.w << 16), __uint_as_float(raw.w & 0xffff0000u)};
            const float mean = wave_sum((v0.x + v0.y) + (v0.z + v0.w) + (v1.x + v1.y) + (v1.z + v1.w)) * (1.f / 512.f);
            v0 = v0 - mean; v1 = v1 - mean;
            const float var = wave_sum((v0.x * v0.x + v0.y * v0.y) + (v0.z * v0.z + v0.w * v0.w) + (v1.x * v1.x + v1.y * v1.y) + (v1.z * v1.z + v1.w * v1.w)) * (1.f / 512.f);
            const float rstd = 1.f / sqrtf(var + LN_EPS);
            v0 = v0 * rstd * g0 + b0; v1 = v1 * rstd * g1 + b1;
            v4u o; o.x = pk2(v0.x, v0.y); o.y = pk2(v0.z, v0.w); o.z = pk2(v1.x, v1.y); o.w = pk2(v1.z, v1.w);
            *(LAS v4u*)(img + s * 1024 + ((lane ^ sgu_f(s)) << 4)) = o; }
        }
        LDS_WAIT(); __syncthreads();
        const int g = w >> 1, cbase = 64 * w;
        const bf16* wg = wtril + (size_t)g * 128 * 128;
        for (int tt = 0; tt < 8; ++tt) {
            f4 acc[4];
#pragma unroll
            for (int dt = 0; dt < 4; ++dt) acc[dt] = (f4){0.f, 0.f, 0.f, 0.f};
            const int nks = (tt >> 1) + 1;
            for (int ks = 0; ks < nks; ++ks) {
                const bf16x8 bw = *(const GAS bf16x8*)(wg + (size_t)(16 * tt + li) * 128 + 32 * ks + 8 * G);
                const int q = li >> 2, p = li & 3;
                const int s0 = 32 * ks + 8 * G + q, s1 = s0 + 4;
#pragma unroll
                for (int dt = 0; dt < 4; ++dt) { const int ch = cbase + 16 * dt + 4 * p;
                    const s16x4 a0 = lds_tr16(img + s0 * 1024 + (((ch >> 3) ^ sgu_f(s0)) << 4) + ((ch & 7) << 1));
                    const s16x4 a1 = lds_tr16(img + s1 * 1024 + (((ch >> 3) ^ sgu_f(s1)) << 4) + ((ch & 7) << 1));
                    const bf16x8 av = (bf16x8){a0[0], a0[1], a0[2], a0[3], a1[0], a1[1], a1[2], a1[3]};
                    acc[dt] = __builtin_amdgcn_mfma_f32_16x16x32_bf16(av, bw, acc[dt], 0, 0, 0); }
            }
            const int t = 16 * tt + li; const float bias = bs[g * 128 + t];
#pragma unroll
            for (int dt = 0; dt < 4; ++dt) { const int ch = cbase + 16 * dt + 4 * G; const size_t off = (size_t)(t0 + t) * 512 + ch;
                const v2u ur = *(const GAS v2u*)(U + off);
                const float u0 = __uint_as_float(ur.x << 16), u1 = __uint_as_float(ur.x & 0xffff0000u), u2 = __uint_as_float(ur.y << 16), u3 = __uint_as_float(ur.y & 0xffff0000u);
                v2u o; o.x = pk2(u0 * (acc[dt][0] + bias), u1 * (acc[dt][1] + bias)); o.y = pk2(u2 * (acc[dt][2] + bias), u3 * (acc[dt][3] + bias));
                *(GAS v2u*)(OUT + off) = o; }
        }
        __syncthreads();
    }
}

constexpr int DSA_LIST_OFF = LDSX_OFF;
static_assert(DSA_LIST_OFF + 4096 <= LDSCTL_OFF, "DSA LDS extras");
__device__ __forceinline__ unsigned mono_key(float f) { const unsigned u = __float_as_uint(f); return (u & 0x80000000u) ? ~u : (u | 0x80000000u); }
__device__ __forceinline__ unsigned mbcnt64(unsigned long long m) { return __builtin_amdgcn_mbcnt_hi((unsigned)(m >> 32), __builtin_amdgcn_mbcnt_lo((unsigned)m, 0u)); }
__device__ __forceinline__ unsigned wave_prefix_incl(unsigned v) {
    v += (unsigned)__builtin_amdgcn_update_dpp(0, (int)v, 0x111, 0xf, 0xf, false);
    v += (unsigned)__builtin_amdgcn_update_dpp(0, (int)v, 0x112, 0xf, 0xf, false);
    v += (unsigned)__builtin_amdgcn_update_dpp(0, (int)v, 0x114, 0xf, 0xf, false);
    v += (unsigned)__builtin_amdgcn_update_dpp(0, (int)v, 0x118, 0xf, 0xf, false);
    v += (unsigned)__builtin_amdgcn_update_dpp(0, (int)v, 0x142, 0xa, 0xf, false);
    v += (unsigned)__builtin_amdgcn_update_dpp(0, (int)v, 0x143, 0xc, 0xf, false);
    return v;
}
__device__ __forceinline__ unsigned rdlane(unsigned v, int l) { return (unsigned)__builtin_amdgcn_readlane((int)v, l); }
__device__ __forceinline__ void lds_inc(LAS unsigned* p) { (void)__hip_atomic_fetch_add(p, 1u, __ATOMIC_RELAXED, __HIP_MEMORY_SCOPE_WORKGROUP); }
__device__ __forceinline__ float xmax16(float x) { const auto r = __builtin_amdgcn_permlane16_swap(__float_as_uint(x), __float_as_uint(x), false, false); return fmaxf(__uint_as_float(r[0]), __uint_as_float(r[1])); }
__device__ __forceinline__ float xmax32(float x) { const auto r = __builtin_amdgcn_permlane32_swap(__float_as_uint(x), __float_as_uint(x), false, false); return fmaxf(__uint_as_float(r[0]), __uint_as_float(r[1])); }
__device__ __forceinline__ void glds16(const void* gsrc, unsigned lds_dst) {
    unsigned keep;
    asm volatile("s_mov_b32 %0, m0\n\ts_mov_b32 m0, %2\n\ts_nop 0\n\tglobal_load_lds_dwordx4 %1, off\n\ts_mov_b32 m0, %0" : "=&s"(keep) : "v"(gsrc), "s"(lds_dst) : "memory");
}

template <int PER>
__device__ __forceinline__ unsigned hist_find(LAS unsigned* h, int lane, unsigned& need, unsigned& cnt) {
    const int sb = 63 - lane; unsigned ssum = 0;
    if (PER == 64) {
#pragma unroll
        for (int i = 0; i < 16; ++i) { const v4u x = *(LAS v4u*)(h + 64 * sb + 4 * ((i + lane) & 15)); ssum += (x.x + x.y) + (x.z + x.w); }
    } else {
#pragma unroll
        for (int i = 0; i < 4; ++i) { const v4u x = *(LAS v4u*)(h + 16 * sb + 4 * ((i + (lane >> 2)) & 3)); ssum += (x.x + x.y) + (x.z + x.w); }
    }
    const unsigned incl = wave_prefix_incl(ssum), above = incl - ssum;
    const unsigned long long hm = __ballot(above < need && incl >= need);
    const int L = hm ? (int)__builtin_ctzll(hm) : 0;
    const unsigned aboveL = rdlane(above, L); const int SB = 63 - L;
    const unsigned c = (lane < PER) ? h[PER * SB + (PER - 1 - lane)] : 0u;
    const unsigned incl2 = wave_prefix_incl(c), above2 = aboveL + incl2 - c;
    const unsigned long long hm2 = __ballot(above2 < need && above2 + c >= need);
    const int L2 = hm2 ? (int)__builtin_ctzll(hm2) : 0;
    const unsigned bin = (unsigned)(PER * SB + (PER - 1 - L2));
    need = need - rdlane(above2, L2); cnt = rdlane(c, L2);
    return bin;
}

__device__ __forceinline__ void dsa_select(LAS float* row, LAS unsigned short* list, int N, int lane) {
    unsigned k[64];
    const int nblk = (N + 255) >> 8;
    const unsigned inval = (unsigned)lane << 20;
#pragma unroll
    for (int i = 0; i < 16; ++i) { if (i < nblk) { const f32x4 v = ((const LAS f32x4*)row)[64 * i + lane];
        if (256 * (i + 1) <= N) {
#pragma unroll
            for (int c = 0; c < 4; ++c) k[4 * i + c] = mono_key(v[c]);
        } else {
#pragma unroll
            for (int c = 0; c < 4; ++c) k[4 * i + c] = (256 * i + 4 * lane + c < N) ? mono_key(v[c]) : inval; } } }
    LDS_WAIT();
    LAS unsigned* hist = (LAS unsigned*)row;
#pragma unroll
    for (int i = 0; i < 16; ++i) ((LAS v4u*)row)[64 * i + lane] = (v4u){0u, 0u, 0u, 0u};
#pragma unroll
    for (int i = 0; i < 16; ++i) { if (i < nblk) {
#pragma unroll
        for (int c = 0; c < 4; ++c) lds_inc((LAS unsigned*)((LAS unsigned char*)hist + ((k[4 * i + c] >> 18) & 0x3ffcu))); } }
    LDS_WAIT();
    unsigned need = 256u, cB;
    const unsigned B = hist_find<64>(hist, lane, need, cB);
    unsigned thr, ties;
    if (cB <= 1024u) {
        LAS unsigned long long* buf = (LAS unsigned long long*)row;
        LAS unsigned* h2 = (LAS unsigned*)row + 2560;
        const unsigned lowkey = B << 20; unsigned nge = 0;
        const unsigned dummy = 10240u + 8u * (unsigned)lane;
        LDS_WAIT();
#pragma unroll
        for (int i = 0; i < 16; ++i) { if (i < nblk) {
            unsigned cnt = 0;
#pragma unroll
            for (int c = 0; c < 4; ++c) cnt += (k[4 * i + c] >= lowkey) ? 1u : 0u;
            const unsigned incl = wave_prefix_incl(cnt);
            unsigned off = (nge + incl - cnt) * 8u;
            nge += rdlane(incl, 63);
#pragma unroll
            for (int c = 0; c < 4; ++c) { const bool ge = k[4 * i + c] >= lowkey;
                *(LAS unsigned long long*)((LAS unsigned char*)row + (ge ? off : dummy)) = ((unsigned long long)k[4 * i + c] << 32) | (unsigned)(256 * i + 4 * lane + c);
                off += ge ? 8u : 0u; }
            if ((i & 3) == 3) __builtin_amdgcn_sched_barrier(0); } }
        LDS_WAIT();
#pragma unroll
        for (int i = 0; i < 4; ++i) ((LAS v4u*)h2)[64 * i + lane] = (v4u){0u, 0u, 0u, 0u};
        LDS_WAIT();
        for (unsigned e = lane; e < nge; e += 64) { const unsigned key = (unsigned)(buf[e] >> 32); if ((key >> 20) == B) lds_inc(h2 + ((key >> 10) & 1023u)); }
        LDS_WAIT();
        unsigned c2;
        const unsigned B2 = hist_find<16>(h2, lane, need, c2);
        const unsigned pre2 = (B << 10) | B2;
#pragma unroll
        for (int i = 0; i < 4; ++i) ((LAS v4u*)h2)[64 * i + lane] = (v4u){0u, 0u, 0u, 0u};
        LDS_WAIT();
        for (unsigned e = lane; e < nge; e += 64) { const unsigned key = (unsigned)(buf[e] >> 32); if ((key >> 10) == pre2) lds_inc(h2 + (key & 1023u)); }
        LDS_WAIT();
        unsigned c3;
        const unsigned B3 = hist_find<16>(h2, lane, need, c3);
        thr = (pre2 << 10) | B3; ties = need;
        unsigned out = 0, eqseen = 0;
        for (unsigned e0 = 0; e0 < nge; e0 += 64) { const unsigned e = e0 + lane; const bool valid = e < nge;
            const unsigned long long ent = valid ? buf[e] : 0ull; const unsigned key = (unsigned)(ent >> 32);
            const bool gt = valid && key > thr, eq = valid && key == thr;
            const unsigned long long meq = __ballot(eq);
            const bool take = gt || (eq && (eqseen + mbcnt64(meq) < ties)); eqseen += (unsigned)__builtin_popcountll(meq);
            const unsigned long long msel = __ballot(take);
            if (take) { const unsigned p = out + mbcnt64(msel); if (p < 256u) list[p] = (unsigned short)(unsigned)ent; }
            out += (unsigned)__builtin_popcountll(msel); }
    } else {
        LAS unsigned* kr = (LAS unsigned*)row;
        LDS_WAIT();
#pragma unroll
        for (int i = 0; i < 16; ++i) { v4u o;
#pragma unroll
            for (int c = 0; c < 4; ++c) o[c] = (i < nblk) ? k[4 * i + c] : 0u;
            ((LAS v4u*)kr)[64 * i + lane] = o; }
        LDS_WAIT();
        unsigned P = B << 20;
        for (int bit = 19; bit >= 0; --bit) { const unsigned trial = P | (1u << bit); unsigned c = 0;
#pragma unroll 4
            for (int j = 0; j < 64; ++j) c += (kr[64 * j + lane] >= trial) ? 1u : 0u;
            const unsigned tot = rdlane(wave_prefix_incl(c), 63);
            if (tot >= 256u) P = trial; }
        unsigned cgt = 0;
#pragma unroll 4
        for (int j = 0; j < 64; ++j) cgt += (kr[64 * j + lane] > P) ? 1u : 0u;
        thr = P; ties = 256u - rdlane(wave_prefix_incl(cgt), 63);
        unsigned out = 0, eqseen = 0;
#pragma unroll 2
        for (int j = 0; j < 64; ++j) { const unsigned kk = kr[64 * j + lane]; const bool gt = kk > thr, eq = kk == thr;
            const unsigned long long meq = __ballot(eq);
            const bool take = gt || (eq && (eqseen + mbcnt64(meq) < ties)); eqseen += (unsigned)__builtin_popcountll(meq);
            const unsigned long long msel = __ballot(take);
            if (take) { const unsigned p = out + mbcnt64(msel); if (p < 256u) list[p] = (unsigned short)(64 * j + lane); }
            out += (unsigned)__builtin_popcountll(msel); }
    }
}

__device__ __forceinline__ void dsa_phase(const Frame& F, const bf16* Q, const bf16* KV, const bf16* QI, const bf16* KI, const float* WI, bf16* ATT) {
    typedef float f4 __attribute__((ext_vector_type(4)));
    int lane = F.lane; asm volatile("" : "+v"(lane)); int w = F.wave; asm volatile("" : "+s"(w));
    LAS unsigned char* lds = F.lds;
    LAS float* sc = (LAS float*)(lds + RING_OFF);
    LAS unsigned short* list = (LAS unsigned short*)(lds + DSA_LIST_OFF) + w * 256;
    constexpr int CPB = 256 / NB, NPER = 512 / CPB;
    const int b = F.vcu / CPB, lc = F.vcu % CPB;
    for (int j = 0; j < NPER; ++j) {
        const int qb = j * CPB + ((j & 1) ? (CPB - 1 - lc) : lc);
        const size_t tb = (size_t)b * SEQ;
        const int q0 = 8 * qb;
        unsigned pf = 0u;
        if (j + 1 < NPER) { const int qbn = (j + 1) * CPB + (((j + 1) & 1) ? (CPB - 1 - lc) : lc); const size_t tn = tb + 8 * (size_t)qbn;
            if (w == 0 && lane < 32) pf = *(const GAS unsigned*)((const char*)(QI + tn * 256) + lane * 128);
            if (w == 1) pf = *(const GAS unsigned*)((const char*)(Q + tn * 512) + lane * 128);
            if (w == 2 && lane == 0) pf = *(const GAS unsigned*)(WI + tn * 4); }
        const int t = q0 + w, N = t + 1;
        const int nsel = N < 256 ? N : 256;
        LAS float* row = sc + w * 4096;
        REP(12) {
        if (rep_ > 0) { LDS_WAIT(); __syncthreads(); }
        REP(11) {
            int lane_s = lane; asm volatile("" : "+v"(lane_s)); const int G = lane_s >> 4, li = lane_s & 15;
            bf16x8 aq[2][2]; f4 wq[2];
#pragma unroll
            for (int rt = 0; rt < 2; ++rt) { const size_t tq = tb + q0 + 4 * rt + (li >> 2);
#pragma unroll
                for (int ks = 0; ks < 2; ++ks) aq[rt][ks] = *(const GAS bf16x8*)(QI + tq * 256 + (li & 3) * 64 + 32 * ks + 8 * G);
                wq[rt] = *(const GAS f4*)(WI + (tb + q0 + 4 * rt + G) * 4); }
            const int ntiles = (q0 + 8 + 15) >> 4;
            for (int tile0 = w; tile0 < ntiles; tile0 += 32) {
                bf16x8 bk[4][2];
#pragma unroll
                for (int u = 0; u < 4; ++u) { const int tile = tile0 + 8 * u;
                    if (tile < ntiles) { const bf16* kr = KI + ((tb >> 4) + tile) * 1024 + lane_s * 8; bk[u][0] = *(const GAS bf16x8*)kr; bk[u][1] = *(const GAS bf16x8*)(kr + 512); } }
#pragma unroll
                for (int u = 0; u < 4; ++u) { const int tile = tile0 + 8 * u;
                    if (tile < ntiles) {
#pragma unroll
                        for (int rt = 0; rt < 2; ++rt) { f4 c = (f4){0.f, 0.f, 0.f, 0.f};
                            c = __builtin_amdgcn_mfma_f32_16x16x32_bf16(aq[rt][0], bk[u][0], c, 0, 0, 0);
                            c = __builtin_amdgcn_mfma_f32_16x16x32_bf16(aq[rt][1], bk[u][1], c, 0, 0, 0);
                            float a = 0.f;
#pragma unroll
                            for (int h = 0; h < 4; ++h) a = fmaf(fmaxf(c[h], 0.f), wq[rt][h], a);
                            sc[(4 * rt + G) * 4096 + 16 * tile + li] = a; } } }
            }
        }
        LDS_WAIT(); __syncthreads();
        {
        if (N <= 256) {
#pragma unroll
            for (int i = 0; i < 4; ++i) list[64 * i + lane] = (unsigned short)((64 * i + lane) < N ? (64 * i + lane) : 0);
        } else { int lane_t = lane; asm volatile("" : "+v"(lane_t)); dsa_select(row, list, N, lane_t); }
        }
        }
        LDS_WAIT();
        REP(13) {
            int lane_a = lane; asm volatile("" : "+v"(lane_a)); const int G = lane_a >> 4, li = lane_a & 15;
            const size_t tq = tb + t;
            long qf[2][2];
#pragma unroll
            for (int g = 0; g < 2; ++g)
#pragma unroll
                for (int ks = 0; ks < 2; ++ks) { v4u raw = (v4u){0u, 0u, 0u, 0u};
                    if (li < 4) raw = *(const GAS v4u*)(Q + tq * 512 + (4 * g + li) * 64 + 32 * ks + 8 * G);
                    const float f0 = __uint_as_float(raw.x << 16), f1 = __uint_as_float(raw.x & 0xffff0000u), f2 = __uint_as_float(raw.y << 16), f3 = __uint_as_float(raw.y & 0xffff0000u);
                    const float f4_ = __uint_as_float(raw.z << 16), f5 = __uint_as_float(raw.z & 0xffff0000u), f6 = __uint_as_float(raw.w << 16), f7 = __uint_as_float(raw.w & 0xffff0000u);
                    int w0 = __builtin_amdgcn_cvt_pk_fp8_f32(f0, f1, 0, false); w0 = __builtin_amdgcn_cvt_pk_fp8_f32(f2, f3, w0, true);
                    int w1 = __builtin_amdgcn_cvt_pk_fp8_f32(f4_, f5, 0, false); w1 = __builtin_amdgcn_cvt_pk_fp8_f32(f6, f7, w1, true);
                    qf[g][ks] = (long)(((unsigned long long)(unsigned)w1 << 32) | (unsigned)w0); }
            asm volatile("" : "+v"(qf[0][0]), "+v"(qf[0][1]), "+v"(qf[1][0]), "+v"(qf[1][1]));
            f4 o[2][4]; float mrun[2], lrun[2];
#pragma unroll
            for (int g = 0; g < 2; ++g) { mrun[g] = -INFINITY; lrun[g] = 0.f;
#pragma unroll
                for (int dt = 0; dt < 4; ++dt) o[g][dt] = (f4){0.f, 0.f, 0.f, 0.f}; }
            LAS unsigned char* buf = (LAS unsigned char*)row;
            const unsigned bufaddr = (unsigned)__builtin_amdgcn_readfirstlane((int)(unsigned)(unsigned long)buf);
            const int nch = (nsel + 31) >> 5;
            const char* kvb = (const char*)KV + tb * 256;
            unsigned voff[8];
#pragma unroll
            for (int i = 0; i < 8; ++i) { const int slot = 4 * i + (lane_a >> 4); voff[i] = (unsigned)(((lane_a & 15) ^ ((slot & 15) ^ ((slot >> 4) << 3))) << 4); }
#define DSA_ISSUE(cc) do { unsigned kv_[8]; \
                _Pragma("unroll") for (int i = 0; i < 8; ++i) kv_[i] = list[32 * (cc) + 4 * i + (lane_a >> 4)]; \
                const unsigned dst_ = bufaddr + (unsigned)(((cc) & 1) * 8192); \
                _Pragma("unroll") for (int i = 0; i < 8; ++i) glds16(kvb + (size_t)kv_[i] * 256 + voff[i], dst_ + i * 1024); } while (0)
            DSA_ISSUE(0);
            for (int c = 0; c < nch; ++c) {
                LAS unsigned char* cb = buf + (c & 1) * 8192;
                if (c + 1 < nch) { DSA_ISSUE(c + 1); asm volatile("s_waitcnt vmcnt(8)" ::: "memory"); }
                else asm volatile("s_waitcnt vmcnt(0)" ::: "memory");
                long kf[2][2][2], vf[2][4];
#pragma unroll
                for (int T = 0; T < 2; ++T) { const int fs = li ^ (8 * T);
#pragma unroll
                    for (int g = 0; g < 2; ++g)
#pragma unroll
                        for (int ks = 0; ks < 2; ++ks) kf[T][g][ks] = *(const LAS long*)(cb + (16 * T + li) * 256 + (((g * 4 + ks * 2 + (G >> 1)) ^ fs) << 4) + ((G & 1) << 3)); }
                { const int q = li >> 1, p = li & 1, slot = (q < 4) ? (4 * G + q) : (16 + 4 * G + q - 4), fs = (slot & 15) ^ ((slot >> 4) << 3);
                  typedef int v2i_t __attribute__((ext_vector_type(2)));
#pragma unroll
                  for (int g = 0; g < 2; ++g)
#pragma unroll
                    for (int dt = 0; dt < 4; ++dt) { const v2i_t r_ = __builtin_amdgcn_ds_read_tr8_b64_v2i32((LAS v2i_t*)(cb + slot * 256 + (((8 + g * 4 + dt) ^ fs) << 4) + (p << 3)));
                        vf[g][dt] = (long)(((unsigned long long)(unsigned)r_[1] << 32) | (unsigned)r_[0]); } }
                LDS_WAIT();
                f4 s[2][2];
#pragma unroll
                for (int T = 0; T < 2; ++T)
#pragma unroll
                for (int g = 0; g < 2; ++g) { s[T][g] = (f4){0.f, 0.f, 0.f, 0.f};
                    s[T][g] = __builtin_amdgcn_mfma_f32_16x16x32_fp8_fp8(kf[T][g][0], qf[g][0], s[T][g], 0, 0, 0);
                    s[T][g] = __builtin_amdgcn_mfma_f32_16x16x32_fp8_fp8(kf[T][g][1], qf[g][1], s[T][g], 0, 0, 0); }
                float lmax[2];
#pragma unroll
                for (int g = 0; g < 2; ++g) {
#pragma unroll
                    for (int T = 0; T < 2; ++T) {
#pragma unroll
                        for (int r = 0; r < 4; ++r) s[T][g][r] *= 0.18033688011112042f;
                        if (32 * c + 32 > nsel) {
#pragma unroll
                            for (int r = 0; r < 4; ++r) if (32 * c + 16 * T + 4 * G + r >= nsel) s[T][g][r] = -INFINITY; } }
                    lmax[g] = fmaxf(fmaxf(fmaxf(s[0][g][0], s[0][g][1]), fmaxf(s[0][g][2], s[0][g][3])), fmaxf(fmaxf(s[1][g][0], s[1][g][1]), fmaxf(s[1][g][2], s[1][g][3]))); }
                if (__ballot(lmax[0] > mrun[0] + 8.f || lmax[1] > mrun[1] + 8.f)) {
#pragma unroll
                    for (int g = 0; g < 2; ++g) { const float cmax = xmax32(xmax16(lmax[g])); const float mnew = fmaxf(mrun[g], cmax);
                        const float alpha = __builtin_amdgcn_exp2f(mrun[g] - mnew); mrun[g] = mnew; lrun[g] *= alpha;
#pragma unroll
                        for (int dt = 0; dt < 4; ++dt) o[g][dt] = o[g][dt] * alpha; } }
#pragma unroll
                for (int g = 0; g < 2; ++g) { float p[8];
#pragma unroll
                    for (int T = 0; T < 2; ++T)
#pragma unroll
                        for (int r = 0; r < 4; ++r) p[4 * T + r] = __builtin_amdgcn_exp2f(s[T][g][r] - mrun[g]);
                    lrun[g] += ((p[0] + p[1]) + (p[2] + p[3])) + ((p[4] + p[5]) + (p[6] + p[7]));
                    int w0 = __builtin_amdgcn_cvt_pk_fp8_f32(p[0], p[1], 0, false); w0 = __builtin_amdgcn_cvt_pk_fp8_f32(p[2], p[3], w0, true);
                    int w1 = __builtin_amdgcn_cvt_pk_fp8_f32(p[4], p[5], 0, false); w1 = __builtin_amdgcn_cvt_pk_fp8_f32(p[6], p[7], w1, true);
                    const long pb = (long)(((unsigned long long)(unsigned)w1 << 32) | (unsigned)w0);
#pragma unroll
                    for (int dt = 0; dt < 4; ++dt) o[g][dt] = __builtin_amdgcn_mfma_f32_16x16x32_fp8_fp8(vf[g][dt], pb, o[g][dt], 0, 0, 0); }
            }
#undef DSA_ISSUE
#pragma unroll
            for (int g = 0; g < 2; ++g) { float l = lrun[g]; l += __shfl_xor(l, 16); l += __shfl_xor(l, 32); const float inv = 1.f / l;
                if (li < 4) {
#pragma unroll
                    for (int dt = 0; dt < 4; ++dt) { v2u ov; ov.x = pk2(o[g][dt][0] * inv, o[g][dt][1] * inv); ov.y = pk2(o[g][dt][2] * inv, o[g][dt][3] * inv);
                        *(GAS v2u*)(ATT + tq * 512 + (4 * g + li) * 64 + 16 * dt + 4 * G) = ov; } } }
        }
        asm volatile("" :: "v"(pf));
        VM_WAIT(); LDS_WAIT(); __syncthreads();
    }
}


#ifndef MK_N_LAUNCHES
#define MK_N_LAUNCHES 1
#endif
#ifndef MK_COOP
#define MK_COOP 1
#endif
constexpr int NPHASE = 1 + 8 * NLAYER;
__global__ void __launch_bounds__(NTHREADS, 2) mega_fwd(PArgs args) {
    extern __shared__ __attribute__((aligned(16))) unsigned char lds_raw[];
    Frame F;
    F.lds = (LAS unsigned char*)lds_raw;
    F.tid = threadIdx.x; F.lane = F.tid & 63; F.wave = __builtin_amdgcn_readfirstlane(F.tid >> 6);
    F.G = gridDim.x; { const int bx = blockIdx.x; F.vcu = (F.G % 8 == 0) ? (bx % 8) * (F.G / 8) + bx / 8 : bx; }
    gu32* ctl = (gu32*)(args.ws + WS_CTL);
    for (int u = F.tid; u < (LDS_BYTES - LDSCTL_OFF) / 4; u += NTHREADS) ((LAS unsigned*)(F.lds + LDSCTL_OFF))[u] = 0u;
    __syncthreads();
    const int lo = args.ph_lo, hi = args.ph_hi;
#if MK_COOP
    if (lo < 0) cooperative_groups::this_grid().sync();
#endif
    const bool use_bar = (hi - lo) > 1;
    XcdBarrier bar; bar.bar = (unsigned*)(ctl + CW_BAR); bar.x = 0; bar.st = nullptr;
    if (use_bar) bar = xcd_barrier_post((unsigned*)(ctl + CW_BAR), (volatile LAS unsigned*)(F.lds + MISC_OFF) + 8);
#define IN(k) (lo <= (k) && (k) < hi)
#define SEAM(k) do { if (IN((k) + 1)) { xcd_barrier(bar); if (MK_DUP == 10) xcd_barrier(bar); } } while (0)

#define ARGS_HERE const __attribute__((address_space(4))) PArgs* ap = (const __attribute__((address_space(4))) PArgs*)__builtin_amdgcn_kernarg_segment_ptr(); asm volatile("" : "+s"(ap)); unsigned char* ws = ap->ws;
#define SEAM0() SEAM(0)
    if (IN(0)) { ARGS_HERE; PArgs a2; for (int i = 0; i < 16; ++i) a2.in[i] = ap->in[i]; a2.out = ap->out; a2.ws = ws; REP(9) p0_prologue(F, a2); SEAM0(); }
#pragma unroll 1
    for (int l = 0; l < NLAYER; ++l) {
        const int pb = 1 + 8 * l;
        if (IN(pb + 0)) {
            ARGS_HERE; const bf16* XB = (const bf16*)(ws + WS_XB); const bf16* win = (const bf16*)(ws + WS_WIN) + (size_t)l * NINP * D;
            pg8::Gemm g{XB, XB, win, win, M, NINP, D}; pg8::StaticOrder S; S.init(M, NINP, F.G, (int)blockIdx.x);
            pg8::EpiInProj E{(bf16*)(ws + WS_Q), (bf16*)(ws + WS_KV), (bf16*)(ws + WS_QI), (bf16*)(ws + WS_KI), (bf16*)(ws + WS_U), (bf16*)(ws + WS_VG), (bf16*)(ws + WS_GR), (bf16*)(ws + WS_GB),
                             (float*)(ws + WS_WI), (const float*)(ws + WS_COS)};
            REP(1) pg8::gemm_phase<pg8::EpiInProj, pg8::StaticOrder, true, true>(F.lds + RING_OFF, g, S, E);
            SEAM(pb + 0);
        }
        if (IN(pb + 1)) {
            REP(2) { ARGS_HERE;
              sgu_phase(F, (const bf16*)(ws + WS_VG), (const bf16*)(ws + WS_U), ap->in[5] + (size_t)l * 512, ap->in[6] + (size_t)l * 512,
                        (const bf16*)(ws + WS_WTRIL) + (size_t)l * 4 * 128 * 128, ap->in[4] + (size_t)l * 4 * 128, (bf16*)(ws + WS_SGU)); }
            REP(3) { ARGS_HERE;
              dsa_phase(F, (const bf16*)(ws + WS_Q), (const bf16*)(ws + WS_KV), (const bf16*)(ws + WS_QI), (const bf16*)(ws + WS_KI), (const float*)(ws + WS_WI), (bf16*)(ws + WS_ATT)); }
            SEAM(pb + 1);
        }
        if (IN(pb + 2)) {
            ARGS_HERE; const bf16* woa = (const bf16*)(ws + WS_WOA) + (size_t)l * D * 512; const bf16* wob = (const bf16*)(ws + WS_WOB) + (size_t)l * D * 512;
            pg8::Gemm g{(const bf16*)(ws + WS_ATT), (const bf16*)(ws + WS_SGU), woa, wob, M, D, 512}; pg8::DualOrder S; S.init(M, D, F.G, (int)blockIdx.x);
            pg8::EpiDual E{(const bf16*)(ws + WS_GR), (const bf16*)(ws + WS_GB), (bf16*)(ws + WS_MERGED)};
            REP(4) pg8::gemm_phase<pg8::EpiDual, pg8::DualOrder, true, true>(F.lds + RING_OFF, g, S, E);
            SEAM(pb + 2);
        }
        if (IN(pb + 3)) {
            ARGS_HERE; const bf16* wout = (const bf16*)(ws + WS_WOUT) + (size_t)l * D * D;
            pg8::Gemm g{(const bf16*)(ws + WS_MERGED), (const bf16*)(ws + WS_MERGED), wout, wout, M, D, D}; pg8::StaticOrder S; S.init(M, D, F.G, (int)blockIdx.x);
            if (l == 0) { pg8::EpiResid E{ap->in[0], ap->out, D, ALPHA};
                for (int rep_ = 0; rep_ < ((MK_DUP == 5) ? 3 : 1); ++rep_) pg8::gemm_phase<pg8::EpiResid, pg8::StaticOrder, true, true>(F.lds + RING_OFF, g, S, E); }
            else { pg8::EpiResidLN E{ap->out, (const float*)(ws + WS_STAT), ap->in[14] + (size_t)(l - 1) * D, ap->in[15] + (size_t)(l - 1) * D, D, ALPHA};
                pg8::gemm_phase<pg8::EpiResidLN, pg8::StaticOrder, true, true>(F.lds + RING_OFF, g, S, E); }
            SEAM(pb + 3);
        }
        if (IN(pb + 4)) {
            ARGS_HERE;
            if (MK_DUP == 7) ln_phase_probe(F, ap->out, ap->in[10] + (size_t)l * D, ap->in[11] + (size_t)l * D, (bf16*)(ws + WS_ATT));
            ln_phase(F, ap->out, ap->in[10] + (size_t)l * D, ap->in[11] + (size_t)l * D, (bf16*)(ws + WS_XB), (float*)(ws + WS_STAT));
            SEAM(pb + 4);
        }
        if (IN(pb + 5)) {
            ARGS_HERE; const bf16* XB = (const bf16*)(ws + WS_XB); const bf16* wff1 = (const bf16*)(ws + WS_WFF1) + (size_t)l * FF * D;
            pg8::Gemm g{XB, XB, wff1, wff1, M, FF, D}; pg8::StaticOrder S; S.init(M, FF, F.G, (int)blockIdx.x);
            pg8::EpiRelu2 E{(bf16*)(ws + WS_H), FF};
            REP(6) pg8::gemm_phase<pg8::EpiRelu2, pg8::StaticOrder, true, true>(F.lds + RING_OFF, g, S, E);
            SEAM(pb + 5);
        }
        if (IN(pb + 6)) {
            ARGS_HERE; const bf16* wff2 = (const bf16*)(ws + WS_WFF2) + (size_t)l * D * FF;
            pg8::Gemm g{(const bf16*)(ws + WS_H), (const bf16*)(ws + WS_H), wff2, wff2, M, D, FF}; pg8::StaticOrder S; S.init(M, D, F.G, (int)blockIdx.x);
            pg8::EpiResidLN E{ap->out, (const float*)(ws + WS_STAT), ap->in[10] + (size_t)l * D, ap->in[11] + (size_t)l * D, D, ALPHA};
            pg8::gemm_phase<pg8::EpiResidLN, pg8::StaticOrder, true, true>(F.lds + RING_OFF, g, S, E);
            SEAM(pb + 6);
        }
        if (IN(pb + 7)) {
            ARGS_HERE;
            ln_phase(F, ap->out, ap->in[14] + (size_t)l * D, ap->in[15] + (size_t)l * D, l + 1 < NLAYER ? (bf16*)(ws + WS_XB) : nullptr, l + 1 < NLAYER ? (float*)(ws + WS_STAT) : nullptr);
            SEAM(pb + 7);
        }
    }
#undef IN
#undef SEAM
}

extern "C" void kernel_launch(void* const* d_in, const int* in_sizes, int n_in, void* d_out, int out_size, void* d_ws, size_t ws_size, hipStream_t stream) {
    static int grid = 0;
    if (grid == 0) {
        if (n_in != 16 || ws_size < WS_END) { fprintf(stderr, "kernel_launch: need 16 inputs and >= %zu bytes of workspace; got n_in %d, ws %zu; nothing launched\n", (size_t)WS_END, n_in, ws_size); grid = -1; return; }
        int dev = 0, cus = 0, per_cu = 0;
        if (hipGetDevice(&dev) != hipSuccess || hipDeviceGetAttribute(&cus, hipDeviceAttributeMultiprocessorCount, dev) != hipSuccess) { fprintf(stderr, "kernel_launch: device query failed\n"); grid = -1; return; }
        if (hipFuncSetAttribute((const void*)mega_fwd, hipFuncAttributeMaxDynamicSharedMemorySize, LDS_BYTES) != hipSuccess) { fprintf(stderr, "kernel_launch: hipFuncSetAttribute failed\n"); grid = -1; return; }
        if (hipOccupancyMaxActiveBlocksPerMultiprocessor(&per_cu, (const void*)mega_fwd, NTHREADS, LDS_BYTES) != hipSuccess || per_cu < 1) { fprintf(stderr, "kernel_launch: occupancy query reports %d blocks per CU for %d threads + %d B LDS; nothing launched\n", per_cu, NTHREADS, LDS_BYTES); grid = -1; return; }
        (void)hipGetLastError();
        if (cus != 256) { fprintf(stderr, "kernel_launch: built for 256 CUs, device has %d; nothing launched\n", cus); grid = -1; return; }
        grid = cus * (per_cu < 1 ? per_cu : 1);
    }
    if (grid < 0) return;
    if (hipMemsetAsync((char*)d_ws + WS_CTL, 0, CTL_ZERO_BYTES, stream) != hipSuccess) { fprintf(stderr, "kernel_launch: memset failed\n"); return; }
    PArgs a{};
    for (int i = 0; i < 16; ++i) a.in[i] = (const float*)d_in[i];
    a.out = (float*)d_out; a.ws = (unsigned char*)d_ws;
#if MK_N_LAUNCHES == 1
    a.ph_lo = 0; a.ph_hi = NPHASE;
#if MK_COOP
    { void* kargs[] = {(void*)&a}; const hipError_t ce = hipLaunchCooperativeKernel((const void*)mega_fwd, dim3(grid), dim3(NTHREADS), kargs, LDS_BYTES, stream);
      if (ce != hipSuccess) fprintf(stderr, "kernel_launch: cooperative launch failed: %s (grid %d)\n", hipGetErrorString(ce), grid); }
#else
    hipLaunchKernelGGL(mega_fwd, dim3(grid), dim3(NTHREADS), LDS_BYTES, stream, a);
#endif
#else
    for (int p = 0; p < NPHASE; ++p) { a.ph_lo = p; a.ph_hi = p + 1; hipLaunchKernelGGL(mega_fwd, dim3(grid), dim3(NTHREADS), LDS_BYTES, stream, a); }
#endif
    const hipError_t le = hipPeekAtLastError();
    if (le != hipSuccess) fprintf(stderr, "kernel_launch: launch failed: %s\n", hipGetErrorName(le));
}
```
